# Optimizing an MI355X kernel written in HIP

```python
import math
import jax, jax.numpy as jnp
from jax import lax
import numpy as np

D_MODEL = 1024
BATCH = 16
SEQ = 256
DEPTH = 2
DEC_BATCH = 2
DEC_SEQ = 4096
PAST_LEN = 256

GRID_W = 64
EPS = 1e-6
N_MOD = 6
D_MIX = D_MODEL
A_WIDTH = D_MODEL // 4
B_WIDTH = D_MODEL // 2
C_WIDTH = D_MODEL // 4
SSM_CG = 16
SSM_G = A_WIDTH // SSM_CG
SSM_P = 64
N_DIR = 2
MLA_HEADS = 8
MLA_NOPE = 64
MLA_ROPE = 32
MLA_V = B_WIDTH // MLA_HEADS
MLA_QK = MLA_NOPE + MLA_ROPE
Q_RANK = D_MODEL // 4
KV_RANK = D_MODEL // 8
ROPE_BASE = 10000.0
Q_BLOCK = 128
ATTN_SCALE = 1.0 / math.sqrt(MLA_QK)
GMLP_HEADS = 4
GMLP_CH = C_WIDTH // GMLP_HEADS
CHUNK = 128
OFF_SSM = 0
OFF_Q = OFF_SSM + A_WIDTH
OFF_KV = OFF_Q + Q_RANK
OFF_KR = OFF_KV + KV_RANK
OFF_GM = OFF_KR + MLA_ROPE
IN_COLS = OFF_GM + 2 * C_WIDTH
D_FF = 2816

kernel_name = 'hybrid_s5_mla_gmlp_prefix_dit_step'

F32 = jnp.float32


def _rms(x):
    xf = x.astype(F32)
    return xf * lax.rsqrt(jnp.mean(xf * xf, axis=-1, keepdims=True) + EPS)


def rmsnorm(x, g):
    return (_rms(x) * g.astype(F32)).astype(x.dtype)


def modulate(x, shift, scale):
    return (_rms(x) * (1.0 + scale.astype(F32)) + shift.astype(F32)).astype(x.dtype)


def modulation(cond, w_mod, b_mod):
    m = jax.nn.silu(cond) @ w_mod + b_mod
    m = m.reshape(m.shape[0], 1, N_MOD, D_MODEL)
    return tuple(m[:, :, i] for i in range(N_MOD))


def axial_rope_tables(n_tokens):
    rows = n_tokens // GRID_W
    row = jnp.repeat(jnp.arange(rows, dtype=F32), GRID_W)
    col = jnp.tile(jnp.arange(GRID_W, dtype=F32), rows)
    n_freq = MLA_ROPE // 4
    inv = ROPE_BASE ** (-jnp.arange(n_freq, dtype=F32) / n_freq)
    ang = jnp.concatenate([row[:, None] * inv, col[:, None] * inv], axis=-1)
    return jnp.cos(ang), jnp.sin(ang)


def apply_rope(x, cos, sin):
    x1, x2 = jnp.split(x.astype(F32), 2, axis=-1)
    c = cos[None, :, None, :]
    s = sin[None, :, None, :]
    return jnp.concatenate([x1 * c - x2 * s, x2 * c + x1 * s], axis=-1).astype(x.dtype)


def _scan_combine(e1, e2):
    a1, b1 = e1
    a2, b2 = e2
    return a1 * a2, a2 * b1 + b2


def ssm_direction(u, h0, a_re, a_im, b_re, b_im, c_re, c_im, log_dt, reverse):
    A = lax.complex(a_re.astype(F32), a_im.astype(F32))
    Bm = lax.complex(b_re.astype(F32), b_im.astype(F32))
    Cm = lax.complex(c_re.astype(F32), c_im.astype(F32))
    dt = jnp.exp(log_dt.astype(F32))[:, None]
    a_bar = jnp.exp(A * dt)
    b_bar = ((a_bar - 1.0) / A)[..., None] * Bm
    bu = jnp.einsum('gpc,blgc->blgp', b_bar, u.astype(jnp.complex64))
    edge = -1 if reverse else 0
    bu = bu.at[:, edge].add(a_bar[None] * h0)
    a = jnp.broadcast_to(a_bar, bu.shape)
    _, h = lax.associative_scan(_scan_combine, (a, bu), axis=1, reverse=reverse)
    y = jnp.einsum('gcp,blgp->blgc', Cm, h).real
    h_final = h[:, 0] if reverse else h[:, -1]
    return y, h_final


def mixer_ssm(u, h0_re, h0_im, p):
    bn, L, _ = u.shape
    uf = u.astype(F32).reshape(bn, L, SSM_G, SSM_CG)
    h0 = lax.complex(h0_re.astype(F32), h0_im.astype(F32))
    ys, hs = [], []
    for d in range(N_DIR):
        y_d, h_d = ssm_direction(uf, h0[:, d], p['ssm_a_re'][d], p['ssm_a_im'][d], p['ssm_b_re'][d],
                                 p['ssm_b_im'][d], p['ssm_c_re'][d], p['ssm_c_im'][d], p['ssm_log_dt'][d],
                                 reverse=(d == 1))
        ys.append(y_d)
        hs.append(h_d)
    y = (ys[0] + ys[1]).reshape(bn, L, A_WIDTH) + p['ssm_d'].astype(F32) * u.astype(F32)
    y = jax.nn.gelu(y).astype(u.dtype)
    y = y * jax.nn.sigmoid(y @ p['ssm_w_glu'])
    h_fin = jnp.stack(hs, axis=1)
    return y, h_fin.real, h_fin.imag


def mla_queries(c_q, p, rope):
    bn, L, _ = c_q.shape
    q = (rmsnorm(c_q, p['q_a_norm']) @ p['w_uq']).reshape(bn, L, MLA_HEADS, MLA_QK)
    q = rmsnorm(q, p['q_norm'])
    if rope is not None:
        q = jnp.concatenate([q[..., :MLA_NOPE], apply_rope(q[..., MLA_NOPE:], *rope)], axis=-1)
    return q


def mla_keys_values(ckv, k_rope, p, rope):
    bn, L, _ = ckv.shape
    kv = (ckv @ p['w_ukv']).reshape(bn, L, MLA_HEADS, MLA_NOPE + MLA_V)
    k_nope, v = kv[..., :MLA_NOPE], kv[..., MLA_NOPE:]
    kr = jnp.broadcast_to(k_rope[:, :, None, :], (bn, L, MLA_HEADS, MLA_ROPE)).astype(k_nope.dtype)
    k = rmsnorm(jnp.concatenate([k_nope, kr], axis=-1), p['k_norm'])
    if rope is not None:
        k = jnp.concatenate([k[..., :MLA_NOPE], apply_rope(k[..., MLA_NOPE:], *rope)], axis=-1)
    return k, v


def block_attention(q, k, v):
    bn, L, H, dk = q.shape
    nb = L // Q_BLOCK
    qb = q.reshape(bn, nb, Q_BLOCK, H, dk).transpose(1, 0, 2, 3, 4)

    def one_block(q_blk):
        s = jnp.einsum('bqhd,bkhd->bhqk', q_blk, k).astype(F32) * ATTN_SCALE
        w = jax.nn.softmax(s, axis=-1).astype(v.dtype)
        return jnp.einsum('bhqk,bkhd->bqhd', w, v)

    out = lax.map(one_block, qb)
    return out.transpose(1, 0, 2, 3, 4).reshape(bn, L, H * MLA_V)


def mixer_gmlp(uv, p):
    bn, L, _ = uv.shape
    u, v = uv[..., :C_WIDTH], uv[..., C_WIDTH:]
    v = rmsnorm(v, p['gmlp_v_norm']).reshape(bn, L // CHUNK, CHUNK, GMLP_HEADS, GMLP_CH)
    mixed = jnp.einsum('hqk,bnkhc->bnqhc', p['gmlp_w_s'], v) + p['gmlp_b_s'].T[None, None, :, :, None]
    return u * mixed.reshape(bn, L, C_WIDTH)


def merge_heads(y_a, y_b, y_c, g, w_out):
    y = jnp.concatenate([_rms(y_a), _rms(y_b), _rms(y_c)], axis=-1) * g.astype(F32)
    return y.astype(y_a.dtype) @ w_out


def conv_ffn(h, p):
    up = h @ p['ffn_w_up']
    L = up.shape[1]
    pad = jnp.pad(up, ((0, 0), (1, 1), (0, 0)))
    w = p['ffn_conv_w']
    conv = pad[:, :L] * w[0] + pad[:, 1:L + 1] * w[1] + pad[:, 2:] * w[2] + p['ffn_conv_b']
    gate, val = conv[..., :D_FF], conv[..., D_FF:]
    return (jax.nn.silu(gate) * val) @ p['ffn_w_down']


def trunk_layer(x, mod, p, ctx):
    shift1, scale1, gate1, shift2, scale2, gate2 = mod
    bn, L, _ = x.shape
    h = modulate(x, shift1, scale1)
    z = h @ p['w_in']
    u_ssm = z[..., OFF_SSM:OFF_Q]
    c_q = z[..., OFF_Q:OFF_KV]
    ckv = rmsnorm(z[..., OFF_KV:OFF_KR], p['kv_a_norm'])
    k_rope = z[..., OFF_KR:OFF_GM]
    uv = z[..., OFF_GM:]
    if ctx is None:
        zeros = jnp.zeros((bn, N_DIR, SSM_G, SSM_P), F32)
        y_a, h_re, h_im = mixer_ssm(u_ssm, zeros, zeros, p)
        q = mla_queries(c_q, p, None)
        k, v = mla_keys_values(ckv, k_rope, p, None)
        new_ctx = (ckv, k_rope, h_re, h_im)
    else:
        ckv_c, kr_c, h0_re, h0_im = ctx
        rope = axial_rope_tables(L)
        y_a, _, _ = mixer_ssm(u_ssm, h0_re, h0_im, p)
        q = mla_queries(c_q, p, rope)
        k_l, v_l = mla_keys_values(ckv, k_rope, p, rope)
        k_c, v_c = mla_keys_values(ckv_c.astype(ckv.dtype), kr_c, p, None)
        k = jnp.concatenate([k_c, k_l], axis=1)
        v = jnp.concatenate([v_c.astype(v_l.dtype), v_l], axis=1)
        new_ctx = None
    y_b = block_attention(q, k, v)
    y_c = mixer_gmlp(uv, p)
    x = x + gate1 * merge_heads(y_a, y_b, y_c, p['w_out_norm'], p['w_out'])
    x = x + gate2 * conv_ffn(modulate(x, shift2, scale2), p)
    return x, new_ctx


def setup_inputs(seed: int = 0) -> dict:
    key = jax.random.key(seed)
    ks = iter(jax.random.split(key, 48))

    def nrm(shape, s):
        return jax.random.normal(next(ks), shape, F32) * s

    def gain(shape):
        return 1.0 + nrm(shape, 0.02)

    n_idx = jnp.arange(SSM_P, dtype=F32)
    sh_a = (DEPTH, N_DIR, SSM_G, SSM_P)
    return {
        'x_prompt': nrm((BATCH, SEQ, D_MODEL), 1.0),
        'x_sample': nrm((DEC_BATCH, DEC_SEQ, D_MODEL), 1.0),
        'cache_ckv': nrm((DEC_BATCH, DEPTH, PAST_LEN, KV_RANK), 1.0),
        'cache_krope': nrm((DEC_BATCH, DEPTH, PAST_LEN, MLA_ROPE), 1.0),
        'state_ssm_re': nrm((DEC_BATCH, DEPTH, N_DIR, SSM_G, SSM_P), 0.3),
        'state_ssm_im': nrm((DEC_BATCH, DEPTH, N_DIR, SSM_G, SSM_P), 0.3),
        'c': nrm((DEC_BATCH, D_MODEL), 1.0),
        'c_ctx': nrm((D_MODEL,), 1.0),
        'w_mod': nrm((DEPTH, D_MODEL, N_MOD * D_MODEL), D_MODEL ** -0.5),
        'b_mod': nrm((DEPTH, N_MOD * D_MODEL), 0.02),
        'w_in': nrm((DEPTH, D_MODEL, IN_COLS), D_MODEL ** -0.5),
        'ssm_a_re': -0.5 + nrm(sh_a, 0.01),
        'ssm_a_im': math.pi * n_idx + nrm(sh_a, 0.01),
        'ssm_b_re': nrm((DEPTH, N_DIR, SSM_G, SSM_P, SSM_CG), (2.0 * SSM_CG) ** -0.5),
        'ssm_b_im': nrm((DEPTH, N_DIR, SSM_G, SSM_P, SSM_CG), (2.0 * SSM_CG) ** -0.5),
        'ssm_c_re': nrm((DEPTH, N_DIR, SSM_G, SSM_CG, SSM_P), (2.0 * SSM_P) ** -0.5),
        'ssm_c_im': nrm((DEPTH, N_DIR, SSM_G, SSM_CG, SSM_P), (2.0 * SSM_P) ** -0.5),
        'ssm_log_dt': jax.random.uniform(next(ks), (DEPTH, N_DIR, SSM_G), F32, math.log(1e-3), math.log(1e-1)),
        'ssm_d': nrm((DEPTH, A_WIDTH), 0.5),
        'ssm_w_glu': nrm((DEPTH, A_WIDTH, A_WIDTH), A_WIDTH ** -0.5),
        'q_a_norm': gain((DEPTH, Q_RANK)),
        'kv_a_norm': gain((DEPTH, KV_RANK)),
        'w_uq': nrm((DEPTH, Q_RANK, MLA_HEADS * MLA_QK), Q_RANK ** -0.5),
        'w_ukv': nrm((DEPTH, KV_RANK, MLA_HEADS * (MLA_NOPE + MLA_V)), KV_RANK ** -0.5),
        'q_norm': gain((DEPTH, MLA_QK)),
        'k_norm': gain((DEPTH, MLA_QK)),
        'gmlp_v_norm': gain((DEPTH, C_WIDTH)),
        'gmlp_w_s': nrm((DEPTH, GMLP_HEADS, CHUNK, CHUNK), CHUNK ** -0.5),
        'gmlp_b_s': 1.0 + nrm((DEPTH, GMLP_HEADS, CHUNK), 0.02),
        'w_out_norm': gain((DEPTH, D_MIX)),
        'w_out': nrm((DEPTH, D_MIX, D_MODEL), D_MIX ** -0.5),
        'ffn_w_up': nrm((DEPTH, D_MODEL, 2 * D_FF), D_MODEL ** -0.5),
        'ffn_conv_w': nrm((DEPTH, 3, 2 * D_FF), 3.0 ** -0.5),
        'ffn_conv_b': nrm((DEPTH, 2 * D_FF), 0.02),
        'ffn_w_down': nrm((DEPTH, D_FF, D_MODEL), D_FF ** -0.5),
    }


def reference(x_prompt, x_sample, cache_ckv, cache_krope, state_ssm_re, state_ssm_im, c, c_ctx,
              w_mod, b_mod, w_in, ssm_a_re, ssm_a_im, ssm_b_re, ssm_b_im, ssm_c_re, ssm_c_im,
              ssm_log_dt, ssm_d, ssm_w_glu, q_a_norm, kv_a_norm, w_uq, w_ukv, q_norm, k_norm,
              gmlp_v_norm, gmlp_w_s, gmlp_b_s, w_out_norm, w_out, ffn_w_up, ffn_conv_w, ffn_conv_b,
              ffn_w_down):
    xp = x_prompt
    xs = x_sample
    ckv_list, kr_list, hre_list, him_list = [], [], [], []
    for l in range(DEPTH):
        p = {
            'w_in': w_in[l], 'ssm_a_re': ssm_a_re[l], 'ssm_a_im': ssm_a_im[l], 'ssm_b_re': ssm_b_re[l],
            'ssm_b_im': ssm_b_im[l], 'ssm_c_re': ssm_c_re[l], 'ssm_c_im': ssm_c_im[l],
            'ssm_log_dt': ssm_log_dt[l], 'ssm_d': ssm_d[l], 'ssm_w_glu': ssm_w_glu[l],
            'q_a_norm': q_a_norm[l], 'kv_a_norm': kv_a_norm[l], 'w_uq': w_uq[l], 'w_ukv': w_ukv[l],
            'q_norm': q_norm[l], 'k_norm': k_norm[l], 'gmlp_v_norm': gmlp_v_norm[l],
            'gmlp_w_s': gmlp_w_s[l], 'gmlp_b_s': gmlp_b_s[l], 'w_out_norm': w_out_norm[l],
            'w_out': w_out[l], 'ffn_w_up': ffn_w_up[l], 'ffn_conv_w': ffn_conv_w[l],
            'ffn_conv_b': ffn_conv_b[l], 'ffn_w_down': ffn_w_down[l],
        }
        mod_ctx = modulation(c_ctx[None, :], w_mod[l], b_mod[l])
        xp, (ckv_l, kr_l, hre_l, him_l) = trunk_layer(xp, mod_ctx, p, None)
        ckv_list.append(ckv_l)
        kr_list.append(kr_l)
        hre_list.append(hre_l)
        him_list.append(him_l)
        mod_lat = modulation(c, w_mod[l], b_mod[l])
        xs, _ = trunk_layer(xs, mod_lat, p,
                            (cache_ckv[:, l], cache_krope[:, l], state_ssm_re[:, l], state_ssm_im[:, l]))
    new_ckv = jnp.stack(ckv_list, axis=1)
    new_krope = jnp.stack(kr_list, axis=1)
    new_ssm_re = jnp.stack(hre_list, axis=1)
    new_ssm_im = jnp.stack(him_list, axis=1)
    return (xp, xs, new_ckv, new_krope, new_ssm_re, new_ssm_im)
```

```cpp
#include <hip/hip_runtime.h>
#include <hip/hip_cooperative_groups.h>
#include <cstdio>
#include <cstdint>
namespace cg = cooperative_groups;

#define DI __device__ __forceinline__
typedef unsigned short u16;
typedef __attribute__((ext_vector_type(8))) short bf16x8;
typedef __attribute__((ext_vector_type(4))) short s16x4;
typedef __attribute__((ext_vector_type(16))) float f32x16;
typedef __attribute__((ext_vector_type(2))) float f2v;
typedef __attribute__((ext_vector_type(2))) __bf16 b2v;
#define MFMA(a, b, c) __builtin_amdgcn_mfma_f32_32x32x16_bf16((a), (b), (c), 0, 0, 0)

constexpr int NT = 12288, NCTX = 4096, NKV = 12800;
constexpr int DM = 1024, INC = 1184, DFF = 2816;
constexpr float EPSF = 1e-6f;
constexpr float ATT_S2 = 0.10206207261596577f * 1.4426950408889634f;

constexpr size_t O_CKV = 12582912, O_KR = 13631488, O_SRE = 13893632, O_SIM = 13959168;

constexpr size_t al(size_t x) { return (x + 255) & ~(size_t)255; }
constexpr size_t WS_BAR = 0;
constexpr size_t WS_WIN = 16384;
constexpr size_t WS_WUQ = WS_WIN + al(2ull * 1280 * 1024 * 2);
constexpr size_t WS_WUKV = WS_WUQ + al(2ull * 768 * 256 * 2);
constexpr size_t WS_WGLU = WS_WUKV + al(2ull * 1024 * 128 * 2);
constexpr size_t WS_WOUT = WS_WGLU + al(2ull * 256 * 256 * 2);
constexpr size_t WS_WUP = WS_WOUT + al(2ull * 1024 * 1024 * 2);
constexpr size_t WS_WDN = WS_WUP + al(2ull * 5632 * 1024 * 2);
constexpr size_t WS_MODV = WS_WDN + al(2ull * 1024 * 2816 * 2);
constexpr size_t WS_ABAR = WS_MODV + al(2ull * 3 * 6144 * 4);
constexpr size_t WS_AT = WS_ABAR + al(4096ull * 8);
constexpr size_t WS_BBAR = WS_AT + al(4096ull * 8);
constexpr size_t WS_CBT = WS_BBAR + al(64ull * 4096);
constexpr size_t WS_SBUF = WS_CBT + al(64ull * 4096);
constexpr size_t WS_HST = WS_SBUF + al(6144ull * 64 * 8);
constexpr size_t WS_HBUF = WS_HST + al(6144ull * 64 * 8);
constexpr size_t WS_YCAT = WS_HBUF + al((size_t)NT * 1024 * 2);
constexpr size_t WS_YBF = WS_YCAT + al((size_t)NT * 1024 * 2);
constexpr size_t WS_YCAT2 = WS_YBF + al((size_t)NT * 256 * 2);
constexpr size_t WS_LB = WS_YCAT2 + al((size_t)NT * 512 * 2);
constexpr size_t WS_R = WS_LB + al((size_t)NT * 16 * 4);
constexpr size_t WS_Z = WS_R;
constexpr size_t WS_CQN = WS_Z + al((size_t)NT * INC * 2);
constexpr size_t WS_CKVN = WS_CQN + al((size_t)NT * 256 * 2);
constexpr size_t WS_QRAW = WS_CKVN + al((size_t)NKV * 128 * 2);
constexpr size_t WS_KVRAW = WS_QRAW + al((size_t)NT * 768 * 2);
constexpr size_t WS_QB = WS_KVRAW + al((size_t)NKV * 1024 * 2);
constexpr size_t WS_KB = WS_QB + al((size_t)NT * 768 * 2);
constexpr size_t WS_VTB = WS_KB + al(9830400ull * 2);
constexpr size_t WS_END1 = WS_VTB + al(6553600ull * 2);
constexpr size_t WS_ACT = WS_R;
constexpr size_t WS_HALO = WS_ACT + al((size_t)NT * DFF * 2);
constexpr size_t WS_END2 = WS_HALO + al(96ull * 4 * 5632 * 4);
constexpr size_t WS_TOTAL = WS_END1 > WS_END2 ? WS_END1 : WS_END2;
constexpr size_t K_LAT = 3145728, VT_LAT = 2097152;

constexpr int SMEM_BYTES = 73728;

struct P {
  const float* in[35];
  float* out;
  char* ws;
};

DI unsigned pack2(float a, float b) { f2v v = {a, b}; b2v r = __builtin_convertvector(v, b2v); return __builtin_bit_cast(unsigned, r); }
DI u16 f2bf(float a) { return (u16)(pack2(a, 0.f) & 0xffffu); }
DI float bf2f(u16 v) { return __uint_as_float(((unsigned)v) << 16); }
DI float bflo(unsigned v) { return __uint_as_float(v << 16); }
DI float bfhi(unsigned v) { return __uint_as_float(v & 0xffff0000u); }
DI float shx(float v, int m, int lane) { return __int_as_float(__builtin_amdgcn_ds_bpermute((lane ^ m) << 2, __float_as_int(v))); }
DI float wave_sum(float v, int lane) {
#pragma unroll
  for (int m = 32; m >= 1; m >>= 1) v += shx(v, m, lane);
  return v;
}
DI float wave_max(float v, int lane) {
#pragma unroll
  for (int m = 32; m >= 1; m >>= 1) v = fmaxf(v, shx(v, m, lane));
  return v;
}
DI float siluf(float x) { return x / (1.f + __expf(-x)); }
DI float sigmf(float x) { return 1.f / (1.f + __expf(-x)); }
DI float geluf(float x) {
  float u = 0.7978845608028654f * (x + 0.044715f * x * x * x);
  float e = __expf(-2.f * fabsf(u));
  float t = (1.f - e) / (1.f + e);
  t = u < 0.f ? -t : t;
  return 0.5f * x * (1.f + t);
}
DI void sincos_acc(float th, float& s, float& c) {
  float k = rintf(th * 0.63661977236758134f);
  float r = fmaf(-k, 1.5703125f, th);
  r = fmaf(-k, 4.837512969970703125e-4f, r);
  r = fmaf(-k, 7.54978995489188216e-8f, r);
  float r2 = r * r;
  float sp = r + r * r2 * (-1.6666666667e-1f + r2 * (8.3333333333e-3f + r2 * (-1.984126984e-4f + r2 * 2.755731922e-6f)));
  float cp = 1.f + r2 * (-0.5f + r2 * (4.16666666667e-2f + r2 * (-1.38888888889e-3f + r2 * (2.48015873e-5f + r2 * (-2.755731922e-7f)))));
  int q = ((int)k) & 3;
  s = (q == 0) ? sp : (q == 1) ? cp : (q == 2) ? -sp : -cp;
  c = (q == 0) ? cp : (q == 1) ? -sp : (q == 2) ? -cp : sp;
}
DI int otid(const int wv) {
  unsigned seed = 0u;
  asm volatile("" : "+v"(seed));
  return wv * 64 + (int)__builtin_amdgcn_mbcnt_hi(~0u, __builtin_amdgcn_mbcnt_lo(~0u, seed));
}
#define WSYNC() do { __builtin_amdgcn_fence(__ATOMIC_ACQ_REL, "wavefront"); __builtin_amdgcn_wave_barrier(); } while (0)
DI int cond_idx(int T) { return T < NCTX ? 0 : 1 + ((T - NCTX) >> 12); }
DI const float* xrow(const P& p, int l, int T) {
  if (l == 0) return T < NCTX ? p.in[0] + (size_t)T * DM : p.in[1] + (size_t)(T - NCTX) * DM;
  return p.out + (size_t)T * DM;
}

DI void convT_tile(const float* __restrict__ src, int N, int Nvalid, int K, u16* __restrict__ dst, int n0, int k0, int srccol0, char* smem, const int tid) {
  float* t = (float*)smem;
#pragma unroll
  for (int i = 0; i < 16; ++i) {
    int idx = tid + 256 * i, kl = idx >> 6, nl = idx & 63;
    float v = 0.f;
    if (n0 + nl < Nvalid) v = src[(size_t)(k0 + kl) * N + srccol0 + nl];
    t[kl * 65 + nl] = v;
  }
  __syncthreads();
#pragma unroll
  for (int i = 0; i < 2; ++i) {
    int id = tid + 256 * i, nl = id >> 3, kc = id & 7;
    uint4 o;
    o.x = pack2(t[(8 * kc + 0) * 65 + nl], t[(8 * kc + 1) * 65 + nl]);
    o.y = pack2(t[(8 * kc + 2) * 65 + nl], t[(8 * kc + 3) * 65 + nl]);
    o.z = pack2(t[(8 * kc + 4) * 65 + nl], t[(8 * kc + 5) * 65 + nl]);
    o.w = pack2(t[(8 * kc + 6) * 65 + nl], t[(8 * kc + 7) * 65 + nl]);
    *(uint4*)(dst + (size_t)(n0 + nl) * K + k0 + 8 * kc) = o;
  }
  __syncthreads();
}

DI void phase_prep(const P& p, char* smem, const int wv) {
  const int tid = otid(wv);
  for (int u = blockIdx.x; u < 2 * 2784; u += gridDim.x) {
    int l = u / 2784, r = u % 2784;
    if (r < 320) {
      int nt = r / 16, kt = r % 16;
      convT_tile(p.in[10] + (size_t)l * 1024 * INC, INC, INC, 1024, (u16*)(p.ws + WS_WIN) + (size_t)l * 1280 * 1024, 64 * nt, 64 * kt, 64 * nt, smem, tid);
    } else if (r < 368) {
      int q = r - 320, nt = q / 4, kt = q % 4;
      convT_tile(p.in[22] + (size_t)l * 256 * 768, 768, 768, 256, (u16*)(p.ws + WS_WUQ) + (size_t)l * 768 * 256, 64 * nt, 64 * kt, 64 * nt, smem, tid);
    } else if (r < 400) {
      int q = r - 368, nt = q / 2, kt = q % 2;
      convT_tile(p.in[23] + (size_t)l * 128 * 1024, 1024, 1024, 128, (u16*)(p.ws + WS_WUKV) + (size_t)l * 1024 * 128, 64 * nt, 64 * kt, 64 * nt, smem, tid);
    } else if (r < 416) {
      int q = r - 400, nt = q / 4, kt = q % 4;
      convT_tile(p.in[19] + (size_t)l * 256 * 256, 256, 256, 256, (u16*)(p.ws + WS_WGLU) + (size_t)l * 256 * 256, 64 * nt, 64 * kt, 64 * nt, smem, tid);
    } else if (r < 672) {
      int q = r - 416, nt = q / 16, kt = q % 16;
      convT_tile(p.in[30] + (size_t)l * 1024 * 1024, 1024, 1024, 1024, (u16*)(p.ws + WS_WOUT) + (size_t)l * 1024 * 1024, 64 * nt, 64 * kt, 64 * nt, smem, tid);
    } else if (r < 2080) {
      int q = r - 672, nt = q / 16, kt = q % 16;
      int j = nt >> 1, isval = nt & 1;
      int sc = isval ? (DFF + 64 * j) : 64 * j;
      convT_tile(p.in[31] + (size_t)l * 1024 * 5632, 5632, 5632, 1024, (u16*)(p.ws + WS_WUP) + (size_t)l * 5632 * 1024, 64 * nt, 64 * kt, sc, smem, tid);
    } else {
      int q = r - 2080, nt = q / 44, kt = q % 44;
      convT_tile(p.in[34] + (size_t)l * 2816 * 1024, 1024, 1024, 2816, (u16*)(p.ws + WS_WDN) + (size_t)l * 1024 * 2816, 64 * nt, 64 * kt, 64 * nt, smem, tid);
    }
  }
  for (int u = blockIdx.x; u < 192; u += gridDim.x) {
    int l = u / 96, n0 = (u % 96) * 64;
    float* sl = (float*)smem;
    float* red = sl + 3 * 1024;
    for (int i = tid; i < 3 * 1024; i += 256) {
      int ci = i >> 10, k = i & 1023;
      float c = (ci == 0) ? p.in[7][k] : p.in[6][(ci - 1) * 1024 + k];
      sl[i] = siluf(c);
    }
    __syncthreads();
    int kg = tid >> 4, c4 = tid & 15;
    float a0[4] = {0, 0, 0, 0}, a1[4] = {0, 0, 0, 0}, a2[4] = {0, 0, 0, 0};
    const float* wp = p.in[8] + ((size_t)l * 1024 + kg * 64) * 6144 + n0 + 4 * c4;
#pragma unroll 8
    for (int k = 0; k < 64; ++k) {
      float4 w = *(const float4*)(wp + (size_t)k * 6144);
      float s0 = sl[kg * 64 + k], s1 = sl[1024 + kg * 64 + k], s2 = sl[2048 + kg * 64 + k];
      a0[0] += s0 * w.x; a0[1] += s0 * w.y; a0[2] += s0 * w.z; a0[3] += s0 * w.w;
      a1[0] += s1 * w.x; a1[1] += s1 * w.y; a1[2] += s1 * w.z; a1[3] += s1 * w.w;
      a2[0] += s2 * w.x; a2[1] += s2 * w.y; a2[2] += s2 * w.z; a2[3] += s2 * w.w;
    }
#pragma unroll
    for (int e = 0; e < 4; ++e) {
      red[(kg * 3 + 0) * 64 + 4 * c4 + e] = a0[e];
      red[(kg * 3 + 1) * 64 + 4 * c4 + e] = a1[e];
      red[(kg * 3 + 2) * 64 + 4 * c4 + e] = a2[e];
    }
    __syncthreads();
    if (tid < 192) {
      int ci = tid >> 6, col = tid & 63;
      float s = p.in[9][(size_t)l * 6144 + n0 + col];
#pragma unroll
      for (int g = 0; g < 16; ++g) s += red[(g * 3 + ci) * 64 + col];
      ((float*)(p.ws + WS_MODV))[((size_t)l * 3 + ci) * 6144 + n0 + col] = s;
    }
    __syncthreads();
  }
  for (int u = blockIdx.x; u < 16; u += gridDim.x) {
    int idx = u * 256 + tid;
    int pq = idx & 63, ldg = idx >> 6;
    float are = p.in[11][idx], aim = p.in[12][idx];
    float dt = expf(p.in[17][ldg]);
    float x = are * dt, y = aim * dt;
    float ex = expf(x), sy, cy, sh, ch;
    sincos_acc(y, sy, cy);
    sincos_acc(0.5f * y, sh, ch);
    float abr = ex * cy, abi = ex * sy;
    float nre = expm1f(x) * cy - 2.f * sh * sh, nim = ex * sy;
    float den = are * are + aim * aim;
    float fre = (nre * are + nim * aim) / den, fim = (nim * are - nre * aim) / den;
    ((float2*)(p.ws + WS_ABAR))[idx] = make_float2(abr, abi);
    float tr = abr, ti = abi;
#pragma unroll
    for (int i = 0; i < 6; ++i) { float nr = tr * tr - ti * ti, ni = 2.f * tr * ti; tr = nr; ti = ni; }
    ((float2*)(p.ws + WS_AT))[idx] = make_float2(tr, ti);
    u16* bt = (u16*)(p.ws + WS_BBAR) + (size_t)ldg * 2048;
    u16* ct = (u16*)(p.ws + WS_CBT) + (size_t)ldg * 2048;
    unsigned rre[8], rim[8];
#pragma unroll
    for (int c = 0; c < 16; c += 2) {
      float bre0 = p.in[13][(size_t)idx * 16 + c], bim0 = p.in[14][(size_t)idx * 16 + c];
      float bre1 = p.in[13][(size_t)idx * 16 + c + 1], bim1 = p.in[14][(size_t)idx * 16 + c + 1];
      rre[c >> 1] = pack2(fre * bre0 - fim * bim0, fre * bre1 - fim * bim1);
      rim[c >> 1] = pack2(fre * bim0 + fim * bre0, fre * bim1 + fim * bre1);
    }
    uint4* bo = (uint4*)(bt + (size_t)(2 * pq) * 16);
    bo[0] = make_uint4(rre[0], rre[1], rre[2], rre[3]); bo[1] = make_uint4(rre[4], rre[5], rre[6], rre[7]);
    bo[2] = make_uint4(rim[0], rim[1], rim[2], rim[3]); bo[3] = make_uint4(rim[4], rim[5], rim[6], rim[7]);
#pragma unroll
    for (int c = 0; c < 16; ++c) {
      float cr = p.in[15][((size_t)ldg * 16 + c) * 64 + pq], ci = p.in[16][((size_t)ldg * 16 + c) * 64 + pq];
      *(unsigned*)(ct + c * 128 + 2 * pq) = pack2(cr, -ci);
    }
  }
}

DI void phase_prenorm(const P& p, int l, int which, const int wv) {
  const int tid = otid(wv); const int lane = tid & 63, w = tid >> 6;
  u16* hb = (u16*)(p.ws + WS_HBUF);
  const float* modv = (const float*)(p.ws + WS_MODV);
  int ci_cur = -1;
  float4 s4c[4], c4c[4];
#pragma unroll
  for (int i = 0; i < 4; ++i) { s4c[i] = make_float4(0.f, 0.f, 0.f, 0.f); c4c[i] = s4c[i]; }
  for (int T = blockIdx.x * 4 + w; T < NT; T += gridDim.x * 4) {
    const float* xr = (which == 0) ? xrow(p, l, T) : p.out + (size_t)T * DM;
    float4 v[4];
    float ss = 0.f;
#pragma unroll
    for (int i = 0; i < 4; ++i) {
      v[i] = ((const float4*)xr)[lane + 64 * i];
      ss += v[i].x * v[i].x + v[i].y * v[i].y + v[i].z * v[i].z + v[i].w * v[i].w;
    }
    const int ci = cond_idx(T);
    if (ci != ci_cur) {
      const float* sh = modv + ((size_t)l * 3 + ci) * 6144 + (which ? 3 : 0) * 1024;
      const float* sc = sh + 1024;
#pragma unroll
      for (int i = 0; i < 4; ++i) { s4c[i] = ((const float4*)sh)[lane + 64 * i]; c4c[i] = ((const float4*)sc)[lane + 64 * i]; }
      ci_cur = ci;
    }
    ss = wave_sum(ss, lane);
    float r = rsqrtf(ss * (1.f / 1024.f) + EPSF);
#pragma unroll
    for (int i = 0; i < 4; ++i) {
      const float4 s4 = s4c[i], c4 = c4c[i];
      uint2 o;
      o.x = pack2(v[i].x * r * (1.f + c4.x) + s4.x, v[i].y * r * (1.f + c4.y) + s4.y);
      o.y = pack2(v[i].z * r * (1.f + c4.z) + s4.z, v[i].w * r * (1.f + c4.w) + s4.w);
      *(uint2*)(hb + (size_t)T * DM + 4 * (lane + 64 * i)) = o;
    }
  }
}

constexpr int LROW = 144;
DI void gemm_tile(const u16* __restrict__ A, int lda, int m0, const u16* __restrict__ Bt, int ldb, int n0, int K, char* smem, f32x16 (&acc)[2][2], const int tid) {
  const int lane = tid & 63, w = tid >> 6, r = lane & 31, h = lane >> 5, wm = w >> 1, wn = w & 1;
  char* sA = smem;
  char* sB = smem + 2 * 128 * LROW;
#pragma unroll
  for (int a = 0; a < 2; ++a)
#pragma unroll
    for (int b = 0; b < 2; ++b)
#pragma unroll
      for (int i = 0; i < 16; ++i) acc[a][b][i] = 0.f;
  const int lrow = tid >> 3, lkc = tid & 7;
  const u16* ap = A + (size_t)(m0 + lrow) * lda + 8 * lkc;
  const u16* bp = Bt + (size_t)(n0 + lrow) * ldb + 8 * lkc;
  uint4 a00, a01, a02, a03, b00, b01, b02, b03, a10, a11, a12, a13, b10, b11, b12, b13;
  const int nk = K >> 6;
#define G_LD1(RA, RB, I, KT) RA = *(const uint4*)(ap + (size_t)(32 * I) * lda + (KT) * 64); RB = *(const uint4*)(bp + (size_t)(32 * I) * ldb + (KT) * 64);
#define G_ST1(RA, RB, I, BUF) *(uint4*)(sA + (BUF) * 128 * LROW + (lrow + 32 * I) * LROW + 16 * lkc) = RA; *(uint4*)(sB + (BUF) * 128 * LROW + (lrow + 32 * I) * LROW + 16 * lkc) = RB;
#define G_LOAD0(KT) { G_LD1(a00, b00, 0, KT) G_LD1(a01, b01, 1, KT) G_LD1(a02, b02, 2, KT) G_LD1(a03, b03, 3, KT) }
#define G_LOAD1(KT) { G_LD1(a10, b10, 0, KT) G_LD1(a11, b11, 1, KT) G_LD1(a12, b12, 2, KT) G_LD1(a13, b13, 3, KT) }
#define G_STORE0(BUF) { G_ST1(a00, b00, 0, BUF) G_ST1(a01, b01, 1, BUF) G_ST1(a02, b02, 2, BUF) G_ST1(a03, b03, 3, BUF) }
#define G_STORE1(BUF) { G_ST1(a10, b10, 0, BUF) G_ST1(a11, b11, 1, BUF) G_ST1(a12, b12, 2, BUF) G_ST1(a13, b13, 3, BUF) }
#define G_COMPUTE(BUF) { const char* ab = sA + (BUF) * 128 * LROW + (64 * wm + r) * LROW + 16 * h; \
    const char* bb = sB + (BUF) * 128 * LROW + (64 * wn + r) * LROW + 16 * h; \
    _Pragma("unroll") for (int s = 0; s < 4; ++s) { \
      bf16x8 a0 = *(const bf16x8*)(ab + 32 * s), a1 = *(const bf16x8*)(ab + 32 * LROW + 32 * s); \
      bf16x8 b0 = *(const bf16x8*)(bb + 32 * s), b1 = *(const bf16x8*)(bb + 32 * LROW + 32 * s); \
      acc[0][0] = MFMA(a0, b0, acc[0][0]); acc[0][1] = MFMA(a0, b1, acc[0][1]); \
      acc[1][0] = MFMA(a1, b0, acc[1][0]); acc[1][1] = MFMA(a1, b1, acc[1][1]); } }
  G_LOAD0(0)
  G_LOAD1(1)
  __builtin_amdgcn_sched_barrier(0);
  G_STORE0(0)
  if (2 < nk) G_LOAD0(2)
  __syncthreads();
  for (int kt = 0; kt < nk; kt += 2) {
    G_STORE1(1)
    if (kt + 3 < nk) G_LOAD1(kt + 3)
    __builtin_amdgcn_sched_barrier(0);
    __builtin_amdgcn_s_setprio(1);
    G_COMPUTE(0)
    __builtin_amdgcn_s_setprio(0);
    __builtin_amdgcn_sched_barrier(0);
    __syncthreads();
    if (kt + 2 < nk) G_STORE0(0)
    if (kt + 4 < nk) G_LOAD0(kt + 4)
    __builtin_amdgcn_sched_barrier(0);
    __builtin_amdgcn_s_setprio(1);
    G_COMPUTE(1)
    __builtin_amdgcn_s_setprio(0);
    __builtin_amdgcn_sched_barrier(0);
    __syncthreads();
  }
#undef G_LD1
#undef G_ST1
#undef G_LOAD0
#undef G_LOAD1
#undef G_STORE0
#undef G_STORE1
#undef G_COMPUTE
}
template <class F>
DI void epi(const f32x16 (&acc)[2][2], const int tid, F f) {
  const int lane = tid & 63, w = tid >> 6, r = lane & 31, h = lane >> 5, wm = w >> 1, wn = w & 1;
#pragma unroll
  for (int a = 0; a < 2; ++a)
#pragma unroll
    for (int b = 0; b < 2; ++b)
#pragma unroll
      for (int i = 0; i < 16; ++i) f(64 * wm + 32 * a + (i & 3) + 8 * (i >> 2) + 4 * h, 64 * wn + 32 * b + r, acc[a][b][i]);
}


DI void stage_tile(const f32x16 (&acc)[2][2], const int tid, float* U) {
  epi(acc, tid, [&](int lr, int lc, float v) { U[lr * 132 + lc] = v; });
  __syncthreads();
}
DI void store_tile_bf16(const float* U, const int tid, u16* dst, int ld, int m0, int n0, int ncol_valid) {
  const int cg = tid & 15, rg = tid >> 4;
  if (8 * cg < ncol_valid) {
#pragma unroll
    for (int rr = 0; rr < 8; ++rr) {
      const int row = 8 * rg + rr;
      const float4 a = *(const float4*)(U + row * 132 + 8 * cg), b = *(const float4*)(U + row * 132 + 8 * cg + 4);
      uint4 o; o.x = pack2(a.x, a.y); o.y = pack2(a.z, a.w); o.z = pack2(b.x, b.y); o.w = pack2(b.z, b.w);
      *(uint4*)(dst + (size_t)(m0 + row) * ld + n0 + 8 * cg) = o;
    }
  }
  __syncthreads();
}

DI bool next_tile(int it, int ntiles, int GM, int GN, int NMG, int& mt, int& nt) {
  if (false && gridDim.x == 512) {
    const int g = it * 8 + (blockIdx.x & 7);
    if (g * 64 >= ntiles) return false;
    const int slot = blockIdx.x >> 3;
    const int gm = g % NMG, gn = g / NMG;
    mt = gm * GM + slot % GM; nt = gn * GN + slot / GM;
    return true;
  }
  const int t = blockIdx.x + it * gridDim.x;
  if (t >= ntiles) return false;
  mt = t % 96; nt = t / 96;
  return true;
}

DI void phase_zgemm(const P& p, int l, char* smem, const int wv) {
  const int tid = otid(wv);
  const u16* A = (const u16*)(p.ws + WS_HBUF);
  const u16* B = (const u16*)(p.ws + WS_WIN) + (size_t)l * 1280 * 1024;
  u16* z = (u16*)(p.ws + WS_Z);
  for (int it = 0;; ++it) {
    int mt, nt;
    if (!next_tile(it, 960, 32, 2, 3, mt, nt)) break;
    f32x16 acc[2][2];
    gemm_tile(A, 1024, 128 * mt, B, 1024, 128 * nt, 1024, smem, acc, tid);
    stage_tile(acc, tid, (float*)smem);
    store_tile_bf16((const float*)smem, tid, z, INC, 128 * mt, 128 * nt, INC - 128 * nt);
  }
}

DI void phase_postz(const P& p, int l, const int wv) {
  const int tid = otid(wv); const int lane = tid & 63, w = tid >> 6;
  const u16* z = (const u16*)(p.ws + WS_Z);
  u16* cqn = (u16*)(p.ws + WS_CQN);
  u16* ckvn = (u16*)(p.ws + WS_CKVN);
  const float* qan = p.in[20] + l * 256;
  const float* kvan = p.in[21] + l * 128;
  const float4 gq4 = ((const float4*)qan)[lane];
  const float2 gk2 = ((const float2*)kvan)[lane];
  for (int T = blockIdx.x * 4 + w; T < NKV; T += gridDim.x * 4) {
    if (T < NT) {
      const u16* zr = z + (size_t)T * INC;
      uint2 q = *(const uint2*)(zr + 256 + 4 * lane);
      float q0 = bflo(q.x), q1 = bfhi(q.x), q2 = bflo(q.y), q3 = bfhi(q.y);
      float ss = wave_sum(q0 * q0 + q1 * q1 + q2 * q2 + q3 * q3, lane);
      float r = rsqrtf(ss * (1.f / 256.f) + EPSF);
      const float4 g = gq4;
      uint2 o;
      o.x = pack2(q0 * r * g.x, q1 * r * g.y);
      o.y = pack2(q2 * r * g.z, q3 * r * g.w);
      *(uint2*)(cqn + (size_t)T * 256 + 4 * lane) = o;
      unsigned kv = *(const unsigned*)(zr + 512 + 2 * lane);
      float k0 = bflo(kv), k1 = bfhi(kv);
      float s2 = wave_sum(k0 * k0 + k1 * k1, lane);
      float r2 = rsqrtf(s2 * (1.f / 128.f) + EPSF);
      const float2 g2 = gk2;
      float c0 = k0 * r2 * g2.x, c1 = k1 * r2 * g2.y;
      *(unsigned*)(ckvn + (size_t)T * 128 + 2 * lane) = pack2(c0, c1);
      if (T < NCTX) {
        int s = T >> 8, pos = T & 255;
        *(float2*)(p.out + O_CKV + ((size_t)(s * 2 + l) * 256 + pos) * 128 + 2 * lane) = make_float2(c0, c1);
        if (lane < 32) p.out[O_KR + ((size_t)(s * 2 + l) * 256 + pos) * 32 + lane] = bf2f(zr[640 + lane]);
      }
    } else {
      int R = T - NT, b = R >> 8, j = R & 255;
      float2 c = *(const float2*)(p.in[2] + (((size_t)b * 2 + l) * 256 + j) * 128 + 2 * lane);
      *(unsigned*)(ckvn + (size_t)T * 128 + 2 * lane) = pack2(c.x, c.y);
    }
  }
}

typedef __attribute__((ext_vector_type(4))) float f32x4;
#define MFMA16(a, b, c) __builtin_amdgcn_mfma_f32_16x16x32_bf16((a), (b), (c), 0, 0, 0)
constexpr int SSM_WB = 17152;
DI bf16x8 zero8() { bf16x8 z; for (int i = 0; i < 8; ++i) z[i] = 0; return z; }

DI void phase_ssm1(const P& p, int l, char* smem, const int wv) {
  const int tid = otid(wv); const int lane = tid & 63, w = tid >> 6;
  const int q = lane >> 4, tl = lane & 15;
  const u16* z = (const u16*)(p.ws + WS_Z);
  const float2* abar = (const float2*)(p.ws + WS_ABAR);
  float2* S = (float2*)(p.ws + WS_SBUF);
  float* BUl = (float*)(smem + w * SSM_WB);
  for (int ub = blockIdx.x; ub < 1536; ub += gridDim.x) {
    int u = ub * 4 + w;
    int chain, c, L, Tbase;
    if (u < 2048) { chain = u >> 2; c = u & 3; L = 256; Tbase = (chain >> 5) * 256; }
    else { int qq = u - 2048; chain = 512 + (qq >> 6); c = qq & 63; L = 4096; Tbase = NCTX + ((chain - 512) >> 5) * 4096; }
    int d = (chain >> 4) & 1, g = chain & 15;
    int ldg = (l * 2 + d) * 16 + g;
    float2 a = abar[ldg * 64 + lane];
    const u16* bt = (const u16*)(p.ws + WS_BBAR) + (size_t)ldg * 2048;
    bf16x8 bf[8], uf[4];
#pragma unroll
    for (int nb = 0; nb < 8; ++nb) bf[nb] = (q < 2) ? *(const bf16x8*)(bt + (16 * nb + tl) * 16 + 8 * q) : zero8();
#pragma unroll
    for (int sbi = 0; sbi < 4; ++sbi) {
      int tt = 64 * c + 16 * sbi + tl;
      int pos = d ? (L - 1 - tt) : tt;
      uf[sbi] = (q < 2) ? *(const bf16x8*)(z + (size_t)(Tbase + pos) * INC + 16 * g + 8 * q) : zero8();
    }
    float hr = 0.f, hi = 0.f;
#pragma unroll
    for (int sbi = 0; sbi < 4; ++sbi) {
      WSYNC();
#pragma unroll
      for (int nb = 0; nb < 8; ++nb) {
        f32x4 acc = {0.f, 0.f, 0.f, 0.f};
        acc = MFMA16(bf[nb], uf[sbi], acc);
        *(f32x4*)(BUl + tl * 132 + 16 * nb + 4 * q) = acc;
      }
      WSYNC();
#pragma unroll
      for (int st = 0; st < 16; ++st) {
        float2 bu = *(const float2*)(BUl + st * 132 + 2 * lane);
        float nr = fmaf(a.x, hr, fmaf(-a.y, hi, bu.x));
        float ni = fmaf(a.x, hi, fmaf(a.y, hr, bu.y));
        hr = nr; hi = ni;
      }
    }
    S[(size_t)u * 64 + lane] = make_float2(hr, hi);
  }
}

DI void phase_ssm_carry(const P& p, int l, const int wv) {
  const int tid = otid(wv); const int lane = tid & 63, w = tid >> 6;
  const float2* aT = (const float2*)(p.ws + WS_AT);
  const float2* S = (const float2*)(p.ws + WS_SBUF);
  float2* H = (float2*)(p.ws + WS_HST);
  for (int chain = blockIdx.x * 4 + w; chain < 576; chain += gridDim.x * 4) {
    int d = (chain >> 4) & 1, g = chain & 15;
    int ldg = (l * 2 + d) * 16 + g;
    float2 a = aT[ldg * 64 + lane];
    float hr = 0.f, hi = 0.f;
    int nch, ubase;
    if (chain < 512) { nch = 4; ubase = chain * 4; }
    else {
      nch = 64; ubase = 2048 + (chain - 512) * 64;
      int b = (chain - 512) >> 5;
      size_t si = ((((size_t)b * 2 + l) * 2 + d) * 16 + g) * 64 + lane;
      hr = p.in[4][si]; hi = p.in[5][si];
    }
    for (int c0 = 0; c0 < nch; c0 += 16) {
      float2 sv[16];
#pragma unroll
      for (int j = 0; j < 16; ++j) {
        sv[j] = make_float2(0.f, 0.f);
        if (c0 + j < nch) {
          const float* sp = (const float*)(S + (size_t)(ubase + c0 + j) * 64 + lane);
          sv[j].x = __hip_atomic_load(sp, __ATOMIC_RELAXED, __HIP_MEMORY_SCOPE_AGENT);
          sv[j].y = __hip_atomic_load(sp + 1, __ATOMIC_RELAXED, __HIP_MEMORY_SCOPE_AGENT);
        }
      }
#pragma unroll
      for (int j = 0; j < 16; ++j) {
        if (c0 + j < nch) {
          H[(size_t)(ubase + c0 + j) * 64 + lane] = make_float2(hr, hi);
          float nr = fmaf(a.x, hr, fmaf(-a.y, hi, sv[j].x));
          float ni = fmaf(a.x, hi, fmaf(a.y, hr, sv[j].y));
          hr = nr; hi = ni;
        }
      }
    }
    if (chain < 512) {
      int s = chain >> 5;
      size_t oi = ((((size_t)s * 2 + l) * 2 + d) * 16 + g) * 64 + lane;
      p.out[O_SRE + oi] = hr;
      p.out[O_SIM + oi] = hi;
    }
  }
}

DI void phase_ssm2(const P& p, int l, char* smem, const int wv) {
  const int tid = otid(wv); const int lane = tid & 63, w = tid >> 6;
  const int q = lane >> 4, tl = lane & 15;
  const u16* z = (const u16*)(p.ws + WS_Z);
  const float2* abar = (const float2*)(p.ws + WS_ABAR);
  const float2* H = (const float2*)(p.ws + WS_HST);
  u16* ybf = (u16*)(p.ws + WS_YBF);
  float* BUl = (float*)(smem + w * SSM_WB);
  char* Hl = smem + w * SSM_WB + 8448;
  float* yt = (float*)(smem + w * SSM_WB + 12800);
  for (int ub = blockIdx.x; ub < 768; ub += gridDim.x) {
    int u = ub * 4 + w;
    int slot, g, pc, L, Tbase, nchunk;
    if (u < 1024) { slot = u >> 6; g = (u >> 2) & 15; pc = u & 3; L = 256; Tbase = slot * 256; nchunk = 4; }
    else { int qq = u - 1024; int b = qq >> 10; slot = 16 + b; g = (qq >> 6) & 15; pc = qq & 63; L = 4096; Tbase = NCTX + b * 4096; nchunk = 64; }
    (void)L;
    for (int i = lane; i < 64 * 17; i += 64) yt[i] = 0.f;
    const int Tfin = Tbase + 64 * pc + lane;
    const uint4 uf0 = *(const uint4*)(z + (size_t)Tfin * INC + 16 * g), uf1 = *(const uint4*)(z + (size_t)Tfin * INC + 16 * g + 8);
    const float4 dd0 = *(const float4*)(p.in[18] + l * 256 + 16 * g), dd1 = *(const float4*)(p.in[18] + l * 256 + 16 * g + 4),
                 dd2 = *(const float4*)(p.in[18] + l * 256 + 16 * g + 8), dd3 = *(const float4*)(p.in[18] + l * 256 + 16 * g + 12);
#pragma unroll
    for (int d = 0; d < 2; ++d) {
      int ldg = (l * 2 + d) * 16 + g;
      float2 a = abar[ldg * 64 + lane];
      const u16* bt = (const u16*)(p.ws + WS_BBAR) + (size_t)ldg * 2048;
      const u16* ct = (const u16*)(p.ws + WS_CBT) + (size_t)ldg * 2048;
      bf16x8 bf[8], cf[4], uf[4];
#pragma unroll
      for (int nb = 0; nb < 8; ++nb) bf[nb] = (q < 2) ? *(const bf16x8*)(bt + (16 * nb + tl) * 16 + 8 * q) : zero8();
#pragma unroll
      for (int ks = 0; ks < 4; ++ks) cf[ks] = *(const bf16x8*)(ct + tl * 128 + 32 * ks + 8 * q);
#pragma unroll
      for (int sbi = 0; sbi < 4; ++sbi) {
        int tau = 16 * sbi + tl;
        int pl = d ? (63 - tau) : tau;
        uf[sbi] = (q < 2) ? *(const bf16x8*)(z + (size_t)(Tbase + 64 * pc + pl) * INC + 16 * g + 8 * q) : zero8();
      }
      int chain, cidx, hu;
      if (slot < 16) { chain = (slot * 2 + d) * 16 + g; cidx = d ? (nchunk - 1 - pc) : pc; hu = chain * 4 + cidx; }
      else { chain = ((slot - 16) * 2 + d) * 16 + g; cidx = d ? (nchunk - 1 - pc) : pc; hu = 2048 + chain * 64 + cidx; }
      float2 h0 = H[(size_t)hu * 64 + lane];
      float hr = h0.x, hi = h0.y;
#pragma unroll
      for (int sbi = 0; sbi < 4; ++sbi) {
        WSYNC();
#pragma unroll
        for (int nb = 0; nb < 8; ++nb) {
          f32x4 acc = {0.f, 0.f, 0.f, 0.f};
          acc = MFMA16(bf[nb], uf[sbi], acc);
          *(f32x4*)(BUl + tl * 132 + 16 * nb + 4 * q) = acc;
        }
        WSYNC();
#pragma unroll
        for (int st = 0; st < 16; ++st) {
          float2 bu = *(const float2*)(BUl + st * 132 + 2 * lane);
          float nr = fmaf(a.x, hr, fmaf(-a.y, hi, bu.x));
          float ni = fmaf(a.x, hi, fmaf(a.y, hr, bu.y));
          hr = nr; hi = ni;
          *(unsigned*)(Hl + st * 272 + 4 * lane) = pack2(hr, hi);
        }
        WSYNC();
        f32x4 ya = {0.f, 0.f, 0.f, 0.f};
#pragma unroll
        for (int ks = 0; ks < 4; ++ks) {
          bf16x8 hf = *(const bf16x8*)(Hl + tl * 272 + 64 * ks + 16 * q);
          ya = MFMA16(hf, cf[ks], ya);
        }
#pragma unroll
        for (int j = 0; j < 4; ++j) {
          int tau = 16 * sbi + 4 * q + j;
          int pl = d ? (63 - tau) : tau;
          yt[pl * 17 + tl] += ya[j];
        }
      }
    }
    WSYNC();
    {
      const int T = Tfin;
      const uint4 u0 = uf0, u1 = uf1;
      float uu[16] = {bflo(u0.x), bfhi(u0.x), bflo(u0.y), bfhi(u0.y), bflo(u0.z), bfhi(u0.z), bflo(u0.w), bfhi(u0.w),
                      bflo(u1.x), bfhi(u1.x), bflo(u1.y), bfhi(u1.y), bflo(u1.z), bfhi(u1.z), bflo(u1.w), bfhi(u1.w)};
      const float dd[16] = {dd0.x, dd0.y, dd0.z, dd0.w, dd1.x, dd1.y, dd1.z, dd1.w, dd2.x, dd2.y, dd2.z, dd2.w, dd3.x, dd3.y, dd3.z, dd3.w};
      float yv[16];
#pragma unroll
      for (int cc = 0; cc < 16; ++cc) yv[cc] = geluf(yt[lane * 17 + cc] + dd[cc] * uu[cc]);
      uint4 o0, o1;
      o0.x = pack2(yv[0], yv[1]); o0.y = pack2(yv[2], yv[3]); o0.z = pack2(yv[4], yv[5]); o0.w = pack2(yv[6], yv[7]);
      o1.x = pack2(yv[8], yv[9]); o1.y = pack2(yv[10], yv[11]); o1.z = pack2(yv[12], yv[13]); o1.w = pack2(yv[14], yv[15]);
      uint4* op = (uint4*)(ybf + (size_t)T * 256 + 16 * g);
      op[0] = o0; op[1] = o1;
    }
    __syncthreads();
  }
}

DI void phase_qkv_gemm(const P& p, int l, char* smem, const int wv) {
  const int tid = otid(wv);
  const u16* A1 = (const u16*)(p.ws + WS_CQN);
  const u16* B1 = (const u16*)(p.ws + WS_WUQ) + (size_t)l * 768 * 256;
  u16* q = (u16*)(p.ws + WS_QRAW);
  const u16* A2 = (const u16*)(p.ws + WS_CKVN);
  const u16* B2 = (const u16*)(p.ws + WS_WUKV) + (size_t)l * 1024 * 128;
  u16* kv = (u16*)(p.ws + WS_KVRAW);
  for (int t = blockIdx.x; t < 576 + 800; t += gridDim.x) {
    f32x16 acc[2][2];
    if (t < 576) {
      int mt = t % 96, nt = t / 96;
      gemm_tile(A1, 256, 128 * mt, B1, 256, 128 * nt, 256, smem, acc, tid);
      stage_tile(acc, tid, (float*)smem);
      store_tile_bf16((const float*)smem, tid, q, 768, 128 * mt, 128 * nt, 128);
    } else {
      int t2 = t - 576, mt = t2 % 100, nt = t2 / 100;
      gemm_tile(A2, 128, 128 * mt, B2, 128, 128 * nt, 128, smem, acc, tid);
      stage_tile(acc, tid, (float*)smem);
      store_tile_bf16((const float*)smem, tid, kv, 1024, 128 * mt, 128 * nt, 128);
    }
  }
}

DI void phase_gmlp(const P& p, int l, char* smem, const int wv) {
  const int tid = otid(wv), lane = tid & 63, w = tid >> 6, r = lane & 31, h = lane >> 5;
  const u16* z = (const u16*)(p.ws + WS_Z);
  u16* ycat = (u16*)(p.ws + WS_YCAT);
  float* rr = (float*)smem;
  char* vT = smem + 512;
  char* wsm = smem + 512 + 64 * 272;
  for (int u = blockIdx.x; u < 384; u += gridDim.x) {
    int ch = u >> 2, hd = u & 3, T0 = 128 * ch;
    uint4 uvp[4]; float bqp[4];
#pragma unroll
    for (int ps = 0; ps < 4; ++ps) {
      const int qq = 32 * w + 8 * ps + (lane >> 3);
      uvp[ps] = *(const uint4*)(z + (size_t)(T0 + qq) * INC + 672 + 64 * hd + 8 * (lane & 7));
      bqp[ps] = p.in[28][((size_t)l * 4 + hd) * 128 + qq];
    }
    {
      int k = tid >> 1, half = tid & 1;
      const uint4* vp = (const uint4*)(z + (size_t)(T0 + k) * INC + 928 + 128 * half);
      float ss = 0.f;
#pragma unroll
      for (int i = 0; i < 16; ++i) {
        uint4 v = vp[i];
        float a0 = bflo(v.x), a1 = bfhi(v.x), a2 = bflo(v.y), a3 = bfhi(v.y), a4 = bflo(v.z), a5 = bfhi(v.z), a6 = bflo(v.w), a7 = bfhi(v.w);
        ss += a0 * a0 + a1 * a1 + a2 * a2 + a3 * a3 + a4 * a4 + a5 * a5 + a6 * a6 + a7 * a7;
      }
      ss += shx(ss, 1, lane);
      if (half == 0) rr[k] = rsqrtf(ss * (1.f / 256.f) + EPSF);
    }
    __syncthreads();
    {
      int k = tid >> 1, half = tid & 1;
      float rk = rr[k];
      const uint4* vp = (const uint4*)(z + (size_t)(T0 + k) * INC + 928 + 64 * hd + 32 * half);
      const float* gv = p.in[26] + l * 256 + 64 * hd + 32 * half;
#pragma unroll
      for (int i = 0; i < 4; ++i) {
        uint4 v = vp[i];
        float a[8] = {bflo(v.x), bfhi(v.x), bflo(v.y), bfhi(v.y), bflo(v.z), bfhi(v.z), bflo(v.w), bfhi(v.w)};
#pragma unroll
        for (int e = 0; e < 8; ++e) {
          int c = 32 * half + 8 * i + e;
          *(u16*)(vT + c * 272 + 2 * k) = f2bf(a[e] * rk * gv[8 * i + e]);
        }
      }
      const float* wsrc = p.in[27] + ((size_t)l * 4 + hd) * 16384;
      float4 wq[16];
#pragma unroll
      for (int i = 0; i < 16; ++i) { int idx = tid + 256 * i; wq[i] = *(const float4*)(wsrc + (idx >> 5) * 128 + 4 * (idx & 31)); }
      __builtin_amdgcn_sched_barrier(0);
#pragma unroll
      for (int i = 0; i < 16; ++i) {
        int idx = tid + 256 * i, row = idx >> 5, c4 = idx & 31;
        uint2 o; o.x = pack2(wq[i].x, wq[i].y); o.y = pack2(wq[i].z, wq[i].w);
        *(uint2*)(wsm + row * 272 + 8 * c4) = o;
      }
    }
    __syncthreads();
    f32x16 acc[2];
#pragma unroll
    for (int i = 0; i < 16; ++i) { acc[0][i] = 0.f; acc[1][i] = 0.f; }
#pragma unroll
    for (int s = 0; s < 8; ++s) {
      bf16x8 af = *(const bf16x8*)(wsm + (32 * w + r) * 272 + 32 * s + 16 * h);
      bf16x8 b0 = *(const bf16x8*)(vT + r * 272 + 32 * s + 16 * h);
      bf16x8 b1 = *(const bf16x8*)(vT + (32 + r) * 272 + 32 * s + 16 * h);
      acc[0] = MFMA(af, b0, acc[0]);
      acc[1] = MFMA(af, b1, acc[1]);
    }
    const float* bs = p.in[28] + ((size_t)l * 4 + hd) * 128;
    float* Uw = (float*)wsm;
    WSYNC();
#pragma unroll
    for (int cb = 0; cb < 2; ++cb)
#pragma unroll
      for (int i = 0; i < 16; ++i) Uw[(32 * w + (i & 3) + 8 * (i >> 2) + 4 * h) * 68 + 32 * cb + r] = acc[cb][i];
    WSYNC();
    {
      const int cg = lane & 7, rl = lane >> 3;
#pragma unroll
      for (int ps = 0; ps < 4; ++ps) {
        const int q = 32 * w + 8 * ps + rl;
        const float4 m0 = *(const float4*)(Uw + q * 68 + 8 * cg), m1 = *(const float4*)(Uw + q * 68 + 8 * cg + 4);
        const float bq = bqp[ps];
        const uint4 uv = uvp[ps];
        uint4 o;
        o.x = pack2(bflo(uv.x) * (m0.x + bq), bfhi(uv.x) * (m0.y + bq)); o.y = pack2(bflo(uv.y) * (m0.z + bq), bfhi(uv.y) * (m0.w + bq));
        o.z = pack2(bflo(uv.z) * (m1.x + bq), bfhi(uv.z) * (m1.y + bq)); o.w = pack2(bflo(uv.w) * (m1.z + bq), bfhi(uv.w) * (m1.w + bq));
        *(uint4*)(ycat + (size_t)(T0 + q) * 1024 + 768 + 64 * hd + 8 * cg) = o;
      }
    }
    __syncthreads();
  }
}

DI void phase_qprep(const P& p, int l, const int wv) {
  const int tid = otid(wv); const int lane = tid & 63, w = tid >> 6;
  const int hd = lane >> 3, sub = lane & 7;
  const u16* qraw = (const u16*)(p.ws + WS_QRAW);
  u16* Qb = (u16*)(p.ws + WS_QB);
  const float* qn = p.in[24] + l * 96;
  float qg[8];
#pragma unroll
  for (int e = 0; e < 8; ++e) qg[e] = qn[8 * sub + e];
  const float qgp0 = qn[64 + 2 * sub], qgp1 = qn[65 + 2 * sub], qgq0 = qn[80 + 2 * sub], qgq1 = qn[81 + 2 * sub];
  const float qinv0 = exp2f(-(float)((2 * sub) & 7) * (13.287712379549449f / 8.f)), qinv1 = exp2f(-(float)(((2 * sub) & 7) + 1) * (13.287712379549449f / 8.f));
  for (int T = blockIdx.x * 4 + w; T < NT; T += gridDim.x * 4) {
    const u16* qr = qraw + (size_t)T * 768 + 96 * hd;
    uint4 n = *(const uint4*)(qr + 8 * sub);
    unsigned x1 = *(const unsigned*)(qr + 64 + 2 * sub), x2 = *(const unsigned*)(qr + 80 + 2 * sub);
    float a[8] = {bflo(n.x), bfhi(n.x), bflo(n.y), bfhi(n.y), bflo(n.z), bfhi(n.z), bflo(n.w), bfhi(n.w)};
    float p0 = bflo(x1), p1 = bfhi(x1), q0 = bflo(x2), q1 = bfhi(x2);
    float ss = p0 * p0 + p1 * p1 + q0 * q0 + q1 * q1;
#pragma unroll
    for (int e = 0; e < 8; ++e) ss += a[e] * a[e];
    ss += shx(ss, 1, lane); ss += shx(ss, 2, lane); ss += shx(ss, 4, lane);
    float r = rsqrtf(ss * (1.f / 96.f) + EPSF) * ATT_S2;
#pragma unroll
    for (int e = 0; e < 8; ++e) a[e] *= r * qg[e];
    p0 *= r * qgp0; p1 *= r * qgp1;
    q0 *= r * qgq0; q1 *= r * qgq1;
    if (T >= NCTX) {
      int pos = (T - NCTX) & 4095;
      float pp = (sub < 4) ? (float)(pos >> 6) : (float)(pos & 63);
      float s0, c0, s1, c1;
      sincos_acc(pp * qinv0, s0, c0);
      sincos_acc(pp * qinv1, s1, c1);
      float n0 = p0 * c0 - q0 * s0, m0 = q0 * c0 + p0 * s0;
      float n1 = p1 * c1 - q1 * s1, m1 = q1 * c1 + p1 * s1;
      p0 = n0; q0 = m0; p1 = n1; q1 = m1;
    }
    u16* qo = Qb + ((size_t)T * 8 + hd) * 96;
    uint4 o; o.x = pack2(a[0], a[1]); o.y = pack2(a[2], a[3]); o.z = pack2(a[4], a[5]); o.w = pack2(a[6], a[7]);
    *(uint4*)(qo + 8 * sub) = o;
    *(unsigned*)(qo + 64 + 2 * sub) = pack2(p0, p1);
    *(unsigned*)(qo + 80 + 2 * sub) = pack2(q0, q1);
  }
}

DI void phase_kvprep(const P& p, int l, char* smem, const int wv) {
  const int tid = otid(wv), lane = tid & 63, w = tid >> 6;
  const int hd = lane >> 3, sub = lane & 7;
  const u16* kvraw = (const u16*)(p.ws + WS_KVRAW);
  const u16* z = (const u16*)(p.ws + WS_Z);
  u16* Kb = (u16*)(p.ws + WS_KB);
  u16* Vtb = (u16*)(p.ws + WS_VTB);
  const float* kn = p.in[25] + l * 96;
  float kg[8];
#pragma unroll
  for (int e = 0; e < 8; ++e) kg[e] = kn[8 * sub + e];
  const float kgp0 = kn[64 + 2 * sub], kgp1 = kn[65 + 2 * sub], kgq0 = kn[80 + 2 * sub], kgq1 = kn[81 + 2 * sub];
  const float kinv0 = exp2f(-(float)((2 * sub) & 7) * (13.287712379549449f / 8.f)), kinv1 = exp2f(-(float)(((2 * sub) & 7) + 1) * (13.287712379549449f / 8.f));
  for (int u = (int)gridDim.x - 1 - (int)blockIdx.x; u < 200; u += gridDim.x) {
    int R0 = 64 * u;
    int nk, key0; size_t kbase, vbase; int lat_own = 0, pos0 = 0;
    if (R0 < NCTX) { int s = R0 >> 8; nk = 256; key0 = R0 & 255; kbase = (size_t)s * 8 * 256 * 96; vbase = (size_t)s * 8 * 64 * 256; }
    else if (R0 < NT) { int b = (R0 - NCTX) >> 12; pos0 = (R0 - NCTX) & 4095; nk = 4352; key0 = 256 + pos0; lat_own = 1; kbase = K_LAT + (size_t)b * 8 * 4352 * 96; vbase = VT_LAT + (size_t)b * 8 * 64 * 4352; }
    else { int b = (R0 - NT) >> 8; nk = 4352; key0 = (R0 - NT) & 255; kbase = K_LAT + (size_t)b * 8 * 4352 * 96; vbase = VT_LAT + (size_t)b * 8 * 64 * 4352; }
    const bool is_cache = R0 >= NT;
    uint4 n_n, vv_n; unsigned x1_n = 0u, x2_n = 0u; float c0_n = 0.f, c1_n = 0.f, c2_n = 0.f, c3_n = 0.f;
#define KV_PREFETCH(IT) { const int R_ = R0 + 4 * (IT) + w; const u16* kr_ = kvraw + (size_t)R_ * 1024 + 128 * hd; \
      n_n = *(const uint4*)(kr_ + 8 * sub); vv_n = *(const uint4*)(kr_ + 64 + 8 * sub); \
      if (!is_cache) { x1_n = *(const unsigned*)(z + (size_t)R_ * INC + 640 + 2 * sub); x2_n = *(const unsigned*)(z + (size_t)R_ * INC + 656 + 2 * sub); } \
      else { const float* cr_ = p.in[3] + (((size_t)((R_ - NT) >> 8) * 2 + l) * 256 + ((R_ - NT) & 255)) * 32; \
             c0_n = cr_[2 * sub]; c1_n = cr_[2 * sub + 1]; c2_n = cr_[16 + 2 * sub]; c3_n = cr_[17 + 2 * sub]; } }
    KV_PREFETCH(0)
    for (int it = 0; it < 16; ++it) {
      int kl = 4 * it + w;
      const uint4 n = n_n, vv = vv_n; const unsigned x1 = x1_n, x2 = x2_n; const float cc0 = c0_n, cc1 = c1_n, cc2 = c2_n, cc3 = c3_n;
      if (it + 1 < 16) KV_PREFETCH(it + 1)
      __builtin_amdgcn_sched_barrier(0);
      float a[8] = {bflo(n.x), bfhi(n.x), bflo(n.y), bfhi(n.y), bflo(n.z), bfhi(n.z), bflo(n.w), bfhi(n.w)};
      float p0, p1, q0, q1;
      if (!is_cache) { p0 = bflo(x1); p1 = bfhi(x1); q0 = bflo(x2); q1 = bfhi(x2); }
      else { p0 = cc0; p1 = cc1; q0 = cc2; q1 = cc3; }
      float ss = p0 * p0 + p1 * p1 + q0 * q0 + q1 * q1;
#pragma unroll
      for (int e = 0; e < 8; ++e) ss += a[e] * a[e];
      ss += shx(ss, 1, lane); ss += shx(ss, 2, lane); ss += shx(ss, 4, lane);
      float r = rsqrtf(ss * (1.f / 96.f) + EPSF);
#pragma unroll
      for (int e = 0; e < 8; ++e) a[e] *= r * kg[e];
      p0 *= r * kgp0; p1 *= r * kgp1;
      q0 *= r * kgq0; q1 *= r * kgq1;
      if (lat_own) {
        int pos = pos0 + kl;
        float pp = (sub < 4) ? (float)(pos >> 6) : (float)(pos & 63);
        float s0, c0, s1, c1;
        sincos_acc(pp * kinv0, s0, c0);
        sincos_acc(pp * kinv1, s1, c1);
        float n0 = p0 * c0 - q0 * s0, m0 = q0 * c0 + p0 * s0;
        float n1 = p1 * c1 - q1 * s1, m1 = q1 * c1 + p1 * s1;
        p0 = n0; q0 = m0; p1 = n1; q1 = m1;
      }
      u16* ko = Kb + kbase + ((size_t)hd * nk + key0 + kl) * 96;
      uint4 o; o.x = pack2(a[0], a[1]); o.y = pack2(a[2], a[3]); o.z = pack2(a[4], a[5]); o.w = pack2(a[6], a[7]);
      *(uint4*)(ko + 8 * sub) = o;
      *(unsigned*)(ko + 64 + 2 * sub) = pack2(p0, p1);
      *(unsigned*)(ko + 80 + 2 * sub) = pack2(q0, q1);
      u16 ve[8] = {(u16)(vv.x & 0xffff), (u16)(vv.x >> 16), (u16)(vv.y & 0xffff), (u16)(vv.y >> 16), (u16)(vv.z & 0xffff), (u16)(vv.z >> 16), (u16)(vv.w & 0xffff), (u16)(vv.w >> 16)};
#pragma unroll
      for (int e = 0; e < 8; ++e) *(u16*)(smem + (64 * hd + 8 * sub + e) * 144 + 2 * kl) = ve[e];
    }
    __syncthreads();
#pragma unroll
    for (int i = 0; i < 16; ++i) {
      int id = tid + 256 * i, row = id >> 3, kc = id & 7;
      uint4 v = *(const uint4*)(smem + row * 144 + 16 * kc);
      *(uint4*)(Vtb + vbase + (size_t)row * nk + key0 + 8 * kc) = v;
    }
    __syncthreads();
  }
}

DI void phase_attn(const P& p, int l, char* smem, const int wv) {
  const int tid = otid(wv), lane = tid & 63, w = tid >> 6, r = lane & 31, h = lane >> 5;
  const u16* Qb = (const u16*)(p.ws + WS_QB);
  const u16* Kb = (const u16*)(p.ws + WS_KB);
  const u16* Vtb = (const u16*)(p.ws + WS_VTB);
  u16* ycat = (u16*)(p.ws + WS_YCAT);
  char* sK = smem;
  char* sV = smem + 2 * 64 * 208;
  float gq = 0.f, gk = 0.f;
  for (int d = lane; d < 96; d += 64) { gq = fmaxf(gq, fabsf(p.in[24][l * 96 + d])); gk = fmaxf(gk, fabsf(p.in[25][l * 96 + d])); }
  gq = wave_max(gq, lane); gk = wave_max(gk, lane);
  const float M2 = 96.f * gq * gk * ATT_S2;
  u16* ycat2 = (u16*)(p.ws + WS_YCAT2);
  float* lb = (float*)(p.ws + WS_LB);
  for (int uu = blockIdx.x; uu < 768; uu += gridDim.x) {
    int unit = uu;
    if (gridDim.x == 512 && uu < 512) {
      const int slot = uu >> 3;
      unit = (((uu & 7) + 8 * (slot >> 5)) << 5) | (slot & 31);
    }
    int head, qT0, nk, half; const u16 *Kp, *Vp;
    if (unit < 512) { half = unit & 1; int rest = unit >> 1; int b = rest >> 7; head = (rest >> 4) & 7; int qblk = rest & 15; qT0 = NCTX + b * 4096 + 256 * qblk; nk = 4352;
      Kp = Kb + K_LAT + ((size_t)(b * 8 + head) * 4352) * 96; Vp = Vtb + VT_LAT + ((size_t)(b * 8 + head) * 64) * 4352; }
    else { int u2 = unit - 512; half = u2 & 1; int rest = u2 >> 1; int s = rest >> 3; head = rest & 7; qT0 = 256 * s; nk = 256;
      Kp = Kb + ((size_t)(s * 8 + head) * 256) * 96; Vp = Vtb + ((size_t)(s * 8 + head) * 64) * 256; }
    Kp += (size_t)half * (nk >> 1) * 96;
    Vp += half * (nk >> 1);
    bf16x8 qf[2][6];
#pragma unroll
    for (int qb = 0; qb < 2; ++qb)
#pragma unroll
      for (int s = 0; s < 6; ++s)
        qf[qb][s] = *(const bf16x8*)(Qb + ((size_t)(qT0 + 64 * w + 32 * qb + r) * 8 + head) * 96 + 16 * s + 8 * h);
    f32x16 o[2][2];
#pragma unroll
    for (int a = 0; a < 2; ++a)
#pragma unroll
      for (int b = 0; b < 2; ++b)
#pragma unroll
        for (int i = 0; i < 16; ++i) o[a][b][i] = 0.f;
    float lsum[2] = {0.f, 0.f};
    const int kk0 = tid / 12, kc0 = tid % 12, kk1 = (tid + 256) / 12, kc1 = (tid + 256) % 12, kk2 = (tid + 512) / 12, kc2 = (tid + 512) % 12;
    const int vdv0 = tid >> 3, vkc = tid & 7;
    const unsigned ko0 = tid * 8, ko1 = (tid + 256) * 8, ko2 = (tid + 512) * 8;
    const unsigned vo0 = vdv0 * nk + 8 * vkc, vo1 = (vdv0 + 32) * nk + 8 * vkc;
    const int ks0 = kk0 * 208 + 16 * kc0, ks1 = kk1 * 208 + 16 * kc1, ks2 = kk2 * 208 + 16 * kc2;
    const int vs0 = vdv0 * 144 + 16 * vkc, vs1 = (vdv0 + 32) * 144 + 16 * vkc;
    uint4 rk0 = *(const uint4*)(Kp + ko0), rk1 = *(const uint4*)(Kp + ko1), rk2 = *(const uint4*)(Kp + ko2);
    uint4 rv0 = *(const uint4*)(Vp + vo0), rv1 = *(const uint4*)(Vp + vo1);
    *(uint4*)(sK + ks0) = rk0; *(uint4*)(sK + ks1) = rk1; *(uint4*)(sK + ks2) = rk2;
    *(uint4*)(sV + vs0) = rv0; *(uint4*)(sV + vs1) = rv1;
    __syncthreads();
    const int ntile = nk >> 7;
    for (int kt = 0; kt < ntile; ++kt) {
      const int cur = kt & 1;
      if (kt + 1 < ntile) {
        const int k0 = (kt + 1) * 64;
        const u16* Kt = Kp + k0 * 96;
        const u16* Vt = Vp + k0;
        rk0 = *(const uint4*)(Kt + ko0); rk1 = *(const uint4*)(Kt + ko1); rk2 = *(const uint4*)(Kt + ko2);
        rv0 = *(const uint4*)(Vt + vo0); rv1 = *(const uint4*)(Vt + vo1);
      }
      __builtin_amdgcn_sched_barrier(0);
      const char* kbp = sK + cur * 64 * 208;
      const char* vbp = sV + cur * 64 * 144;
      __builtin_amdgcn_s_setprio(1);
#pragma unroll 1
      for (int kb = 0; kb < 2; ++kb) {
        const char* kfp = kbp + (32 * kb + r) * 208 + 16 * h;
#pragma unroll
        for (int qb = 0; qb < 2; ++qb) {
          f32x16 st;
#pragma unroll
          for (int i = 0; i < 16; ++i) st[i] = -M2;
#pragma unroll
          for (int s = 0; s < 6; ++s) st = MFMA(*(const bf16x8*)(kfp + 32 * s), qf[qb][s], st);
          bf16x8 pf[2];
#pragma unroll
          for (int i = 0; i < 16; ++i) { st[i] = __builtin_amdgcn_exp2f(st[i]); lsum[qb] += st[i]; }
#pragma unroll
          for (int sp = 0; sp < 2; ++sp) {
            uint4 pk;
            pk.x = pack2(st[8 * sp + 0], st[8 * sp + 1]); pk.y = pack2(st[8 * sp + 2], st[8 * sp + 3]);
            pk.z = pack2(st[8 * sp + 4], st[8 * sp + 5]); pk.w = pack2(st[8 * sp + 6], st[8 * sp + 7]);
            pf[sp] = __builtin_bit_cast(bf16x8, pk);
          }
#pragma unroll
          for (int sp = 0; sp < 2; ++sp)
#pragma unroll
            for (int dvb = 0; dvb < 2; ++dvb) {
              const char* va = vbp + (32 * dvb + r) * 144 + (32 * kb + 16 * sp + 4 * h) * 2;
              s16x4 lo = *(const s16x4*)(va), hi = *(const s16x4*)(va + 16);
              bf16x8 vf = __builtin_shufflevector(lo, hi, 0, 1, 2, 3, 4, 5, 6, 7);
              o[dvb][qb] = MFMA(vf, pf[sp], o[dvb][qb]);
            }
        }
      }
      __builtin_amdgcn_s_setprio(0);
      if (kt + 1 < ntile) {
        char* wk = sK + (cur ^ 1) * 64 * 208;
        char* wv = sV + (cur ^ 1) * 64 * 144;
        *(uint4*)(wk + ks0) = rk0; *(uint4*)(wk + ks1) = rk1; *(uint4*)(wk + ks2) = rk2;
        *(uint4*)(wv + vs0) = rv0; *(uint4*)(wv + vs1) = rv1;
      }
      __syncthreads();
    }
    char* Ow = smem + w * 9216;
#pragma unroll
    for (int qb = 0; qb < 2; ++qb) {
      float lt = lsum[qb] + shx(lsum[qb], 32, lane);
      float inv = 1.f / lt;
      const int Tq = qT0 + 64 * w + 32 * qb + r;
      if (h == 0) lb[((size_t)Tq * 8 + head) * 2 + half] = lt;
#pragma unroll
      for (int dvb = 0; dvb < 2; ++dvb)
#pragma unroll
        for (int g = 0; g < 4; ++g) {
          uint2 ov;
          ov.x = pack2(o[dvb][qb][4 * g + 0] * inv, o[dvb][qb][4 * g + 1] * inv);
          ov.y = pack2(o[dvb][qb][4 * g + 2] * inv, o[dvb][qb][4 * g + 3] * inv);
          *(uint2*)(Ow + (32 * qb + r) * 144 + (32 * dvb + 8 * g + 4 * h) * 2) = ov;
        }
    }
    WSYNC();
#pragma unroll
    for (int i = 0; i < 8; ++i) {
      const int id = lane + 64 * i, row = id >> 3, kc = id & 7;
      const uint4 v = *(const uint4*)(Ow + row * 144 + 16 * kc);
      const int Tq = qT0 + 64 * w + row;
      u16* yo = half ? (ycat2 + (size_t)Tq * 512 + 64 * head) : (ycat + (size_t)Tq * 1024 + 256 + 64 * head);
      *(uint4*)(yo + 8 * kc) = v;
    }
    __syncthreads();
  }
}

DI void phase_glu(const P& p, int l, char* smem, const int wv) {
  const int tid = otid(wv);
  const u16* A = (const u16*)(p.ws + WS_YBF);
  const u16* B = (const u16*)(p.ws + WS_WGLU) + (size_t)l * 256 * 256;
  u16* ycat = (u16*)(p.ws + WS_YCAT);
  for (int t = blockIdx.x; t < 192; t += gridDim.x) {
    int mt = t % 96, nt = t / 96;
    f32x16 acc[2][2];
    gemm_tile(A, 256, 128 * mt, B, 256, 128 * nt, 256, smem, acc, tid);
    const int m0 = 128 * mt, n0 = 128 * nt;
    float* U = (float*)smem;
    stage_tile(acc, tid, U);
    {
      const int cg = tid & 15, rg = tid >> 4;
#pragma unroll
      for (int rr = 0; rr < 8; ++rr) {
        const int row = 8 * rg + rr;
        const float4 a = *(const float4*)(U + row * 132 + 8 * cg), b = *(const float4*)(U + row * 132 + 8 * cg + 4);
        const uint4 yv = *(const uint4*)(A + (size_t)(m0 + row) * 256 + n0 + 8 * cg);
        uint4 o;
        o.x = pack2(bflo(yv.x) * sigmf(a.x), bfhi(yv.x) * sigmf(a.y)); o.y = pack2(bflo(yv.y) * sigmf(a.z), bfhi(yv.y) * sigmf(a.w));
        o.z = pack2(bflo(yv.z) * sigmf(b.x), bfhi(yv.z) * sigmf(b.y)); o.w = pack2(bflo(yv.w) * sigmf(b.z), bfhi(yv.w) * sigmf(b.w));
        *(uint4*)(ycat + (size_t)(m0 + row) * 1024 + n0 + 8 * cg) = o;
      }
    }
    __syncthreads();
  }
}

DI void phase_merge(const P& p, int l, const int wv) {
  const int tid = otid(wv); const int lane = tid & 63, w = tid >> 6;
  const u16* ycat = (const u16*)(p.ws + WS_YCAT);
  u16* hb = (u16*)(p.ws + WS_HBUF);
  const float* gn = p.in[29] + l * 1024;
  float4 gh[4];
#pragma unroll
  for (int i = 0; i < 4; ++i) gh[i] = ((const float4*)gn)[lane + 64 * i];
  for (int T = blockIdx.x * 4 + w; T < NT; T += gridDim.x * 4) {
    const uint2* yr = (const uint2*)(ycat + (size_t)T * 1024);
    const uint2* yr2 = (const uint2*)((const u16*)(p.ws + WS_YCAT2) + (size_t)T * 512);
    const float2* lb = (const float2*)(p.ws + WS_LB) + (size_t)T * 8;
    float v[4][4];
    float ss[4];
#pragma unroll
    for (int i = 0; i < 4; ++i) {
      uint2 q = yr[lane + 64 * i];
      v[i][0] = bflo(q.x); v[i][1] = bfhi(q.x); v[i][2] = bflo(q.y); v[i][3] = bfhi(q.y);
      if (i == 1 || i == 2) {
        uint2 q2 = yr2[lane + 64 * (i - 1)];
        float2 lw = lb[4 * (i - 1) + (lane >> 4)];
        float w1 = lw.x / (lw.x + lw.y), w2 = lw.y / (lw.x + lw.y);
        v[i][0] = v[i][0] * w1 + bflo(q2.x) * w2; v[i][1] = v[i][1] * w1 + bfhi(q2.x) * w2;
        v[i][2] = v[i][2] * w1 + bflo(q2.y) * w2; v[i][3] = v[i][3] * w1 + bfhi(q2.y) * w2;
      }
      ss[i] = wave_sum(v[i][0] * v[i][0] + v[i][1] * v[i][1] + v[i][2] * v[i][2] + v[i][3] * v[i][3], lane);
    }
    float ra = rsqrtf(ss[0] * (1.f / 256.f) + EPSF);
    float rb = rsqrtf((ss[1] + ss[2]) * (1.f / 512.f) + EPSF);
    float rc = rsqrtf(ss[3] * (1.f / 256.f) + EPSF);
#pragma unroll
    for (int i = 0; i < 4; ++i) {
      float rr = (i == 0) ? ra : (i == 3) ? rc : rb;
      const float4 g = gh[i];
      uint2 o;
      o.x = pack2(v[i][0] * rr * g.x, v[i][1] * rr * g.y);
      o.y = pack2(v[i][2] * rr * g.z, v[i][3] * rr * g.w);
      *(uint2*)(hb + (size_t)T * 1024 + 4 * (lane + 64 * i)) = o;
    }
  }
}

DI void phase_res_gemm(const P& p, int l, int which, char* smem, const int wv) {
  const int tid = otid(wv);
  const u16* A = which == 0 ? (const u16*)(p.ws + WS_HBUF) : (const u16*)(p.ws + WS_ACT);
  const int K = which == 0 ? 1024 : DFF;
  const u16* B = which == 0 ? (const u16*)(p.ws + WS_WOUT) + (size_t)l * 1024 * 1024 : (const u16*)(p.ws + WS_WDN) + (size_t)l * 1024 * DFF;
  const float* modv = (const float*)(p.ws + WS_MODV);
  for (int it = 0;; ++it) {
    int mt, nt;
    if (!next_tile(it, 768, 16, 4, 6, mt, nt)) break;
    const int m0 = 128 * mt, n0 = 128 * nt;
    const float* gate = modv + ((size_t)l * 3 + cond_idx(m0)) * 6144 + (which == 0 ? 2 : 5) * 1024;
    const int lsel = which == 0 ? l : 1;
    const int cgp = tid & 31, rgp = tid >> 5;
    const float4 gt = *(const float4*)(gate + n0 + 4 * cgp);
    float4 xpre[8];
#pragma unroll
    for (int rr = 0; rr < 8; ++rr) xpre[rr] = *(const float4*)(xrow(p, lsel, m0 + 16 * rgp + rr) + n0 + 4 * cgp);
    __builtin_amdgcn_sched_barrier(0);
    f32x16 acc[2][2];
    gemm_tile(A, K, 128 * mt, B, K, 128 * nt, K, smem, acc, tid);
    float* U = (float*)smem;
    stage_tile(acc, tid, U);
    {
      const int cg = cgp, rg = rgp;
#pragma unroll
      for (int rr = 0; rr < 16; ++rr) {
        const int row = 16 * rg + rr, T = m0 + row;
        const float4 a = *(const float4*)(U + row * 132 + 4 * cg);
        const float4 xin = rr < 8 ? xpre[rr & 7] : *(const float4*)(xrow(p, lsel, T) + n0 + 4 * cg);
        *(float4*)(p.out + (size_t)T * DM + n0 + 4 * cg) = make_float4(xin.x + gt.x * a.x, xin.y + gt.y * a.y, xin.z + gt.z * a.z, xin.w + gt.w * a.w);
      }
    }
    __syncthreads();
  }
}

DI float4 f4fma3(float4 w0, float4 a, float4 w1, float4 b, float4 w2, float4 c, float4 bias) {
  return make_float4(w0.x * a.x + w1.x * b.x + w2.x * c.x + bias.x, w0.y * a.y + w1.y * b.y + w2.y * c.y + bias.y,
                     w0.z * a.z + w1.z * b.z + w2.z * c.z + bias.z, w0.w * a.w + w1.w * b.w + w2.w * c.w + bias.w);
}
DI void phase_ffn_up(const P& p, int l, char* smem, const int wv) {
  const int tid = otid(wv);
  const u16* A = (const u16*)(p.ws + WS_HBUF);
  const u16* B = (const u16*)(p.ws + WS_WUP) + (size_t)l * 5632 * 1024;
  u16* act = (u16*)(p.ws + WS_ACT);
  float* halo = (float*)(p.ws + WS_HALO);
  const float* cw = p.in[32] + (size_t)l * 3 * 5632;
  const float* cb = p.in[33] + (size_t)l * 5632;
  float* U = (float*)smem;
  for (int it = 0;; ++it) {
    int mt, nt;
    if (!next_tile(it, 4224, 16, 4, 6, mt, nt)) break;
    const int chw = 64 * nt + 4 * (tid & 15);
    const float4 w0g = *(const float4*)(cw + chw), w1g = *(const float4*)(cw + 5632 + chw), w2g = *(const float4*)(cw + 2 * 5632 + chw), bg = *(const float4*)(cb + chw);
    const float4 w0v = *(const float4*)(cw + DFF + chw), w1v = *(const float4*)(cw + 5632 + DFF + chw), w2v = *(const float4*)(cw + 2 * 5632 + DFF + chw), bv = *(const float4*)(cb + DFF + chw);
    __builtin_amdgcn_sched_barrier(0);
    f32x16 acc[2][2];
    gemm_tile(A, 1024, 128 * mt, B, 1024, 128 * nt, 1024, smem, acc, tid);
    epi(acc, tid, [&](int lr, int lc, float v) { U[lr * 132 + lc] = v; });
    __syncthreads();
    const int m0 = 128 * mt;
    {
      const int cg = tid & 15, rq = tid >> 4;
      const int ch = 64 * nt + 4 * cg;
      const float4 z4 = make_float4(0.f, 0.f, 0.f, 0.f);
      const int row0 = 8 * rq;
      const float* ug = U + 4 * cg;
      const float* uv = U + 64 + 4 * cg;
      float4 gm = row0 > 0 ? *(const float4*)(ug + (row0 - 1) * 132) : z4, vm = row0 > 0 ? *(const float4*)(uv + (row0 - 1) * 132) : z4;
      float4 g0 = *(const float4*)(ug + row0 * 132), v0 = *(const float4*)(uv + row0 * 132);
      u16* ap = act + (size_t)m0 * DFF + ch;
#pragma unroll
      for (int rr = 0; rr < 8; ++rr) {
        const int row = row0 + rr;
        float4 gp = row < 127 ? *(const float4*)(ug + (row + 1) * 132) : z4, vp = row < 127 ? *(const float4*)(uv + (row + 1) * 132) : z4;
        float4 g = f4fma3(w0g, gm, w1g, g0, w2g, gp, bg);
        float4 v = f4fma3(w0v, vm, w1v, v0, w2v, vp, bv);
        uint2 o;
        o.x = pack2(siluf(g.x) * v.x, siluf(g.y) * v.y);
        o.y = pack2(siluf(g.z) * v.z, siluf(g.w) * v.w);
        *(uint2*)(ap + (size_t)row * DFF) = o;
        gm = g0; vm = v0; g0 = gp; v0 = vp;
      }
      if (tid < 128) {
        float* hp = halo + ((size_t)mt * 4) * 5632 + 128 * nt + tid;
        hp[0] = U[0 * 132 + tid];
        hp[5632] = U[1 * 132 + tid];
        hp[2 * 5632] = U[126 * 132 + tid];
        hp[3 * 5632] = U[127 * 132 + tid];
      }
    }
    __syncthreads();
  }
}

DI void phase_ffn_fix(const P& p, int l, const int wv) {
  const int tid = otid(wv);
  u16* act = (u16*)(p.ws + WS_ACT);
  const float* halo = (const float*)(p.ws + WS_HALO);
  const float* cw = p.in[32] + (size_t)l * 3 * 5632;
  const float* cb = p.in[33] + (size_t)l * 5632;
  for (int u = blockIdx.x; u < 96 * 11; u += gridDim.x) {
    int mt = u / 11, chunk = u % 11;
    int m0 = 128 * mt;
    bool seq_start = (m0 < NCTX) ? ((m0 & 255) == 0) : (((m0 - NCTX) & 4095) == 0);
    if (seq_start) continue;
    int ch = 256 * chunk + tid;
    int j = ch >> 6, c = ch & 63;
    int ng = 128 * j + c, nv = ng + 64;
    const float* Hm = halo + ((size_t)(mt - 1) * 4) * 5632;
    const float* Hc = halo + ((size_t)mt * 4) * 5632;
    const float w0g = cw[ch], w1g = cw[5632 + ch], w2g = cw[2 * 5632 + ch], bg = cb[ch];
    const float w0v = cw[DFF + ch], w1v = cw[5632 + DFF + ch], w2v = cw[2 * 5632 + DFF + ch], bv = cb[DFF + ch];
    {
      float g = w0g * Hm[3 * 5632 + ng] + w1g * Hc[ng] + w2g * Hc[5632 + ng] + bg;
      float v = w0v * Hm[3 * 5632 + nv] + w1v * Hc[nv] + w2v * Hc[5632 + nv] + bv;
      act[(size_t)m0 * DFF + ch] = f2bf(siluf(g) * v);
    }
    {
      float g = w0g * Hm[2 * 5632 + ng] + w1g * Hm[3 * 5632 + ng] + w2g * Hc[ng] + bg;
      float v = w0v * Hm[2 * 5632 + nv] + w1v * Hm[3 * 5632 + nv] + w2v * Hc[nv] + bv;
      act[(size_t)(m0 - 1) * DFF + ch] = f2bf(siluf(g) * v);
    }
  }
}


#define XB_TMO      128
#define XB_XCNT(j)  (256  + 64 * (j))
#define XB_XSUB(j)  (1280 + 64 * (j))
#define XB_XGEN(j)  (2304 + 64 * (j))
#define XB_TOP      3328
#define XB_TOPGEN   3392
#define XCD_BAR_WORDS 3456
#define XB_SPIN_CAP (1u << 18)
#define LAS __attribute__((address_space(3)))
DI unsigned xb_ld(unsigned* p) { return __hip_atomic_load(p, __ATOMIC_RELAXED, __HIP_MEMORY_SCOPE_AGENT); }
DI unsigned xb_add(unsigned* p, unsigned v) { return __hip_atomic_fetch_add(p, v, __ATOMIC_RELAXED, __HIP_MEMORY_SCOPE_AGENT); }
DI unsigned xb_xcc_id() { return (unsigned)__builtin_amdgcn_s_getreg((3 << 11) | 20) & 0xFu; }
#define XB_SPIN(cond, bar) do { unsigned _sp = 0; while (cond) { __builtin_amdgcn_s_sleep(1); \
    if ((++_sp & 255u) == 0u) { if (xb_ld(&(bar)[XB_TMO])) break; if (_sp > XB_SPIN_CAP) { atomicAdd(&(bar)[XB_TMO], 1u); break; } } } } while (0)
struct XcdBarrier { unsigned* bar; unsigned x; volatile LAS unsigned* st; };
DI XcdBarrier xcd_barrier_post(unsigned* bar, volatile LAS unsigned* st, int tid) {
  XcdBarrier b; b.bar = bar; b.x = xb_xcc_id(); b.st = st;
  if (tid == 0) (void)xb_add(&bar[XB_XCNT(b.x)], 1u);
  return b;
}
DI void xcd_barrier_complete(unsigned* bar, unsigned x, unsigned& nloc, unsigned& nx) {
  const unsigned G = gridDim.x * gridDim.y * gridDim.z;
  unsigned sum, cnt, mine, sp = 0u;
  for (;;) {
    sum = 0u; cnt = 0u; mine = 0u;
#pragma unroll
    for (unsigned j = 0; j < 16; ++j) { const unsigned c = xb_ld(&bar[XB_XCNT(j)]); sum += c; cnt += (c > 0u) ? 1u : 0u; mine = (j == x) ? c : mine; }
    if (sum == G) break;
    __builtin_amdgcn_s_sleep(1);
    if ((++sp & 255u) == 0u) { if (xb_ld(&bar[XB_TMO])) break; if (sp > XB_SPIN_CAP) { atomicAdd(&bar[XB_TMO], 1u); break; } }
  }
  nloc = mine > 0u ? mine : 1u; nx = cnt > 0u ? cnt : 1u;
}
DI void xcd_barrier(const XcdBarrier& b, const int wv) {
  asm volatile("s_waitcnt vmcnt(0)" ::: "memory");
  __syncthreads();
  if (otid(wv) == 0) {
    unsigned* bar = b.bar;
    const unsigned bx = xb_xcc_id();
    __builtin_amdgcn_s_waitcnt(0);
    unsigned nloc = b.st[0], nx = b.st[1];
    if (nloc == 0u) { xcd_barrier_complete(bar, bx, nloc, nx); b.st[0] = nloc; b.st[1] = nx; }
    const unsigned old = xb_add(&bar[XB_XSUB(bx)], 1u);
    const unsigned gen = old / nloc;
    if (old + 1u == (gen + 1u) * nloc) {
      __builtin_amdgcn_fence(__ATOMIC_RELEASE, "agent");
      asm volatile("s_waitcnt vmcnt(0)" ::: "memory");
      const unsigned og = xb_add(&bar[XB_TOP], 1u);
      const unsigned tg = og / nx;
      if (og + 1u == (tg + 1u) * nx) xb_add(&bar[XB_TOPGEN], 1u);
      else XB_SPIN(xb_ld(&bar[XB_TOPGEN]) == tg, bar);
      __builtin_amdgcn_fence(__ATOMIC_ACQUIRE, "agent");
      xb_add(&bar[XB_XGEN(bx)], 1u);
      asm volatile("s_waitcnt vmcnt(0)" ::: "memory");
    } else {
      XB_SPIN(xb_ld(&bar[XB_XGEN(bx)]) == gen, bar);
      __builtin_amdgcn_fence(__ATOMIC_ACQUIRE, "agent");
      asm volatile("s_waitcnt vmcnt(0)" ::: "memory");
    }
  }
  __syncthreads();
}

extern __shared__ __attribute__((aligned(16))) char dyn_smem[];

#ifndef DUP_MASK
#define DUP_MASK 0
#endif
#define RUN(bit, call) do { call; if (DUP_MASK & (1u << (bit))) { xcd_barrier(xbar, wv); call; } } while (0)

__global__ void __launch_bounds__(256, 2) fwd_megakernel(P p) {
  char* smem = dyn_smem;
  const int wv = __builtin_amdgcn_readfirstlane(threadIdx.x >> 6);
  __shared__ uint4 xb_words;
  {
    cg::grid_group grid = cg::this_grid();
    if (p.ws == nullptr) grid.sync();
    if (otid(wv) == 0) xb_words = make_uint4(0u, 0u, 0u, 0u);
    __syncthreads();
  }
  const XcdBarrier xbar = xcd_barrier_post((unsigned*)(p.ws + WS_BAR), (volatile LAS unsigned*)&xb_words, otid(wv));
  RUN(0, phase_prep(p, smem, wv));
  xcd_barrier(xbar, wv);
  for (int l = 0; l < 2; ++l) {
    RUN(1, phase_prenorm(p, l, 0, wv));
    xcd_barrier(xbar, wv);
    RUN(2, phase_zgemm(p, l, smem, wv));
    xcd_barrier(xbar, wv);
    RUN(3, phase_postz(p, l, wv));
    RUN(4, phase_ssm1(p, l, smem, wv));
    xcd_barrier(xbar, wv);
    RUN(5, phase_qkv_gemm(p, l, smem, wv));
    RUN(6, phase_gmlp(p, l, smem, wv));
    RUN(7, phase_ssm_carry(p, l, wv));
    xcd_barrier(xbar, wv);
    RUN(8, phase_qprep(p, l, wv));
    RUN(9, phase_kvprep(p, l, smem, wv));
    RUN(10, phase_ssm2(p, l, smem, wv));
    xcd_barrier(xbar, wv);
    RUN(11, phase_attn(p, l, smem, wv));
    RUN(12, phase_glu(p, l, smem, wv));
    xcd_barrier(xbar, wv);
    RUN(13, phase_merge(p, l, wv));
    xcd_barrier(xbar, wv);
    phase_res_gemm(p, l, 0, smem, wv);
    xcd_barrier(xbar, wv);
    RUN(14, phase_prenorm(p, l, 1, wv));
    xcd_barrier(xbar, wv);
    RUN(15, phase_ffn_up(p, l, smem, wv));
    xcd_barrier(xbar, wv);
    RUN(16, phase_ffn_fix(p, l, wv));
    xcd_barrier(xbar, wv);
    phase_res_gemm(p, l, 1, smem, wv);
    if (l == 0) xcd_barrier(xbar, wv);
  }
  if (DUP_MASK & (1u << 31)) { for (int i = 0; i < 20; ++i) xcd_barrier(xbar, wv); }
}

extern "C" void kernel_launch(void* const* d_in, const int* in_sizes, int n_in, void* d_out, int out_size, void* d_ws, size_t ws_size,
                              hipStream_t stream) {
  static int grid_blocks = 0;
  if (!grid_blocks) {
    int dev = 0, cus = 0, per_cu = 0;
    hipGetDevice(&dev);
    hipDeviceGetAttribute(&cus, hipDeviceAttributeMultiprocessorCount, dev);
    hipFuncSetAttribute((const void*)fwd_megakernel, hipFuncAttributeMaxDynamicSharedMemorySize, SMEM_BYTES);
    hipOccupancyMaxActiveBlocksPerMultiprocessor(&per_cu, fwd_megakernel, 256, SMEM_BYTES);
    if (per_cu < 1) per_cu = 1;
    if (per_cu > 2) per_cu = 2;
    grid_blocks = cus * per_cu;
    if (ws_size < WS_TOTAL) fprintf(stderr, "workspace too small: %zu < %zu\n", ws_size, (size_t)WS_TOTAL);
  }
  (void)hipMemsetAsync(d_ws, 0, 16384, stream);
  P p{};
  for (int i = 0; i < 35; ++i) p.in[i] = (const float*)d_in[i];
  p.out = (float*)d_out;
  p.ws = (char*)d_ws;
  void* args[] = {&p};
  hipError_t e = hipLaunchCooperativeKernel((void*)fwd_megakernel, dim3(grid_blocks), dim3(256), args, SMEM_BYTES, stream);
  if (e != hipSuccess) fprintf(stderr, "cooperative launch failed: %s (grid %d)\n", hipGetErrorString(e), grid_blocks);
}
```

```cpp
#include <hip/hip_runtime.h>
#include <hip/hip_cooperative_groups.h>
#include <cstdio>
#include <cstdint>
namespace cg = cooperative_groups;

#define DI __device__ __forceinline__
typedef unsigned short u16;
typedef __attribute__((ext_vector_type(8))) short bf16x8;
typedef __attribute__((ext_vector_type(4))) short s16x4;
typedef __attribute__((ext_vector_type(16))) float f32x16;
typedef __attribute__((ext_vector_type(2))) float f2v;
typedef __attribute__((ext_vector_type(2))) __bf16 b2v;
#define MFMA(a, b, c) __builtin_amdgcn_mfma_f32_32x32x16_bf16((a), (b), (c), 0, 0, 0)

constexpr int NT = 12288, NCTX = 4096, NKV = 12800;
constexpr int DM = 1024, INC = 1184, DFF = 2816;
constexpr float EPSF = 1e-6f;
constexpr float ATT_S2 = 0.10206207261596577f * 1.4426950408889634f;

constexpr size_t O_CKV = 12582912, O_KR = 13631488, O_SRE = 13893632, O_SIM = 13959168;

constexpr size_t al(size_t x) { return (x + 255) & ~(size_t)255; }
constexpr size_t WS_BAR = 0;
constexpr size_t WS_WIN = 16384;
constexpr size_t WS_WUQ = WS_WIN + al(2ull * 1280 * 1024 * 2);
constexpr size_t WS_WUKV = WS_WUQ + al(2ull * 768 * 256 * 2);
constexpr size_t WS_WGLU = WS_WUKV + al(2ull * 1024 * 128 * 2);
constexpr size_t WS_WOUT = WS_WGLU + al(2ull * 256 * 256 * 2);
constexpr size_t WS_WUP = WS_WOUT + al(2ull * 1024 * 1024 * 2);
constexpr size_t WS_WDN = WS_WUP + al(2ull * 5632 * 1024 * 2);
constexpr size_t WS_MODV = WS_WDN + al(2ull * 1024 * 2816 * 2);
constexpr size_t WS_ABAR = WS_MODV + al(2ull * 3 * 6144 * 4);
constexpr size_t WS_AT = WS_ABAR + al(4096ull * 8);
constexpr size_t WS_BBAR = WS_AT + al(4096ull * 8);
constexpr size_t WS_CBT = WS_BBAR + al(64ull * 4096);
constexpr size_t WS_SBUF = WS_CBT + al(64ull * 4096);
constexpr size_t WS_HST = WS_SBUF + al(6144ull * 64 * 8);
constexpr size_t WS_HBUF = WS_HST + al(6144ull * 64 * 8);
constexpr size_t WS_YCAT = WS_HBUF + al((size_t)NT * 1024 * 2);
constexpr size_t WS_YBF = WS_YCAT + al((size_t)NT * 1024 * 2);
constexpr size_t WS_YCAT2 = WS_YBF + al((size_t)NT * 256 * 2);
constexpr size_t WS_LB = WS_YCAT2 + al((size_t)NT * 512 * 2);
constexpr size_t WS_R = WS_LB + al((size_t)NT * 16 * 4);
constexpr size_t WS_Z = WS_R;
constexpr size_t WS_CQN = WS_Z + al((size_t)NT * INC * 2);
constexpr size_t WS_CKVN = WS_CQN + al((size_t)NT * 256 * 2);
constexpr size_t WS_QRAW = WS_CKVN + al((size_t)NKV * 128 * 2);
constexpr size_t WS_KVRAW = WS_QRAW + al((size_t)NT * 768 * 2);
constexpr size_t WS_QB = WS_KVRAW + al((size_t)NKV * 1024 * 2);
constexpr size_t WS_KB = WS_QB + al((size_t)NT * 768 * 2);
constexpr size_t WS_VTB = WS_KB + al(9830400ull * 2);
constexpr size_t WS_END1 = WS_VTB + al(6553600ull * 2);
constexpr size_t WS_ACT = WS_R;
constexpr size_t WS_HALO = WS_ACT + al((size_t)NT * DFF * 2);
constexpr size_t WS_END2 = WS_HALO + al(96ull * 4 * 5632 * 4);
constexpr size_t WS_TOTAL = WS_END1 > WS_END2 ? WS_END1 : WS_END2;
constexpr size_t K_LAT = 3145728, VT_LAT = 2097152;

constexpr int SMEM_BYTES = 73728;

struct P {
  const float* in[35];
  float* out;
  char* ws;
};

DI unsigned pack2(float a, float b) { f2v v = {a, b}; b2v r = __builtin_convertvector(v, b2v); return __builtin_bit_cast(unsigned, r); }
DI u16 f2bf(float a) { return (u16)(pack2(a, 0.f) & 0xffffu); }
DI float bf2f(u16 v) { return __uint_as_float(((unsigned)v) << 16); }
DI float bflo(unsigned v) { return __uint_as_float(v << 16); }
DI float bfhi(unsigned v) { return __uint_as_float(v & 0xffff0000u); }
DI float shx(float v, int m, int lane) { return __int_as_float(__builtin_amdgcn_ds_bpermute((lane ^ m) << 2, __float_as_int(v))); }
DI float wave_sum(float v, int lane) {
#pragma unroll
  for (int m = 32; m >= 1; m >>= 1) v += shx(v, m, lane);
  return v;
}
DI float wave_max(float v, int lane) {
#pragma unroll
  for (int m = 32; m >= 1; m >>= 1) v = fmaxf(v, shx(v, m, lane));
  return v;
}
DI float siluf(float x) { return x / (1.f + __expf(-x)); }
DI float sigmf(float x) { return 1.f / (1.f + __expf(-x)); }
DI float geluf(float x) {
  float u = 0.7978845608028654f * (x + 0.044715f * x * x * x);
  float e = __expf(-2.f * fabsf(u));
  float t = (1.f - e) / (1.f + e);
  t = u < 0.f ? -t : t;
  return 0.5f * x * (1.f + t);
}
DI void sincos_acc(float th, float& s, float& c) {
  float k = rintf(th * 0.63661977236758134f);
  float r = fmaf(-k, 1.5703125f, th);
  r = fmaf(-k, 4.837512969970703125e-4f, r);
  r = fmaf(-k, 7.54978995489188216e-8f, r);
  float r2 = r * r;
  float sp = r + r * r2 * (-1.6666666667e-1f + r2 * (8.3333333333e-3f + r2 * (-1.984126984e-4f + r2 * 2.755731922e-6f)));
  float cp = 1.f + r2 * (-0.5f + r2 * (4.16666666667e-2f + r2 * (-1.38888888889e-3f + r2 * (2.48015873e-5f + r2 * (-2.755731922e-7f)))));
  int q = ((int)k) & 3;
  s = (q == 0) ? sp : (q == 1) ? cp : (q == 2) ? -sp : -cp;
  c = (q == 0) ? cp : (q == 1) ? -sp : (q == 2) ? -cp : sp;
}
DI int otid(const int wv) {
  unsigned seed = 0u;
  asm volatile("" : "+v"(seed));
  return wv * 64 + (int)__builtin_amdgcn_mbcnt_hi(~0u, __builtin_amdgcn_mbcnt_lo(~0u, seed));
}
#define WSYNC() do { __builtin_amdgcn_fence(__ATOMIC_ACQ_REL, "wavefront"); __builtin_amdgcn_wave_barrier(); } while (0)
DI int cond_idx(int T) { return T < NCTX ? 0 : 1 + ((T - NCTX) >> 12); }
DI const float* xrow(const P& p, int l, int T) {
  if (l == 0) return T < NCTX ? p.in[0] + (size_t)T * DM : p.in[1] + (size_t)(T - NCTX) * DM;
  return p.out + (size_t)T * DM;
}

DI void convT_tile(const float* __restrict__ src, int N, int Nvalid, int K, u16* __restrict__ dst, int n0, int k0, int srccol0, char* smem, const int tid) {
  float* t = (float*)smem;
#pragma unroll
  for (int i = 0; i < 16; ++i) {
    int idx = tid + 256 * i, kl = idx >> 6, nl = idx & 63;
    float v = 0.f;
    if (n0 + nl < Nvalid) v = src[(size_t)(k0 + kl) * N + srccol0 + nl];
    t[kl * 65 + nl] = v;
  }
  __syncthreads();
#pragma unroll
  for (int i = 0; i < 2; ++i) {
    int id = tid + 256 * i, nl = id >> 3, kc = id & 7;
    uint4 o;
    o.x = pack2(t[(8 * kc + 0) * 65 + nl], t[(8 * kc + 1) * 65 + nl]);
    o.y = pack2(t[(8 * kc + 2) * 65 + nl], t[(8 * kc + 3) * 65 + nl]);
    o.z = pack2(t[(8 * kc + 4) * 65 + nl], t[(8 * kc + 5) * 65 + nl]);
    o.w = pack2(t[(8 * kc + 6) * 65 + nl], t[(8 * kc + 7) * 65 + nl]);
    *(uint4*)(dst + (size_t)(n0 + nl) * K + k0 + 8 * kc) = o;
  }
  __syncthreads();
}

DI void phase_prep(const P& p, char* smem, const int wv) {
  const int tid = otid(wv);
  for (int u = blockIdx.x; u < 2 * 2784; u += gridDim.x) {
    int l = u / 2784, r = u % 2784;
    if (r < 320) {
      int nt = r / 16, kt = r % 16;
      convT_tile(p.in[10] + (size_t)l * 1024 * INC, INC, INC, 1024, (u16*)(p.ws + WS_WIN) + (size_t)l * 1280 * 1024, 64 * nt, 64 * kt, 64 * nt, smem, tid);
    } else if (r < 368) {
      int q = r - 320, nt = q / 4, kt = q % 4;
      convT_tile(p.in[22] + (size_t)l * 256 * 768, 768, 768, 256, (u16*)(p.ws + WS_WUQ) + (size_t)l * 768 * 256, 64 * nt, 64 * kt, 64 * nt, smem, tid);
    } else if (r < 400) {
      int q = r - 368, nt = q / 2, kt = q % 2;
      convT_tile(p.in[23] + (size_t)l * 128 * 1024, 1024, 1024, 128, (u16*)(p.ws + WS_WUKV) + (size_t)l * 1024 * 128, 64 * nt, 64 * kt, 64 * nt, smem, tid);
    } else if (r < 416) {
      int q = r - 400, nt = q / 4, kt = q % 4;
      convT_tile(p.in[19] + (size_t)l * 256 * 256, 256, 256, 256, (u16*)(p.ws + WS_WGLU) + (size_t)l * 256 * 256, 64 * nt, 64 * kt, 64 * nt, smem, tid);
    } else if (r < 672) {
      int q = r - 416, nt = q / 16, kt = q % 16;
      convT_tile(p.in[30] + (size_t)l * 1024 * 1024, 1024, 1024, 1024, (u16*)(p.ws + WS_WOUT) + (size_t)l * 1024 * 1024, 64 * nt, 64 * kt, 64 * nt, smem, tid);
    } else if (r < 2080) {
      int q = r - 672, nt = q / 16, kt = q % 16;
      int j = nt >> 1, isval = nt & 1;
      int sc = isval ? (DFF + 64 * j) : 64 * j;
      convT_tile(p.in[31] + (size_t)l * 1024 * 5632, 5632, 5632, 1024, (u16*)(p.ws + WS_WUP) + (size_t)l * 5632 * 1024, 64 * nt, 64 * kt, sc, smem, tid);
    } else {
      int q = r - 2080, nt = q / 44, kt = q % 44;
      convT_tile(p.in[34] + (size_t)l * 2816 * 1024, 1024, 1024, 2816, (u16*)(p.ws + WS_WDN) + (size_t)l * 1024 * 2816, 64 * nt, 64 * kt, 64 * nt, smem, tid);
    }
  }
  for (int u = blockIdx.x; u < 192; u += gridDim.x) {
    int l = u / 96, n0 = (u % 96) * 64;
    float* sl = (float*)smem;
    float* red = sl + 3 * 1024;
    for (int i = tid; i < 3 * 1024; i += 256) {
      int ci = i >> 10, k = i & 1023;
      float c = (ci == 0) ? p.in[7][k] : p.in[6][(ci - 1) * 1024 + k];
      sl[i] = siluf(c);
    }
    __syncthreads();
    int kg = tid >> 4, c4 = tid & 15;
    float a0[4] = {0, 0, 0, 0}, a1[4] = {0, 0, 0, 0}, a2[4] = {0, 0, 0, 0};
    const float* wp = p.in[8] + ((size_t)l * 1024 + kg * 64) * 6144 + n0 + 4 * c4;
#pragma unroll 8
    for (int k = 0; k < 64; ++k) {
      float4 w = *(const float4*)(wp + (size_t)k * 6144);
      float s0 = sl[kg * 64 + k], s1 = sl[1024 + kg * 64 + k], s2 = sl[2048 + kg * 64 + k];
      a0[0] += s0 * w.x; a0[1] += s0 * w.y; a0[2] += s0 * w.z; a0[3] += s0 * w.w;
      a1[0] += s1 * w.x; a1[1] += s1 * w.y; a1[2] += s1 * w.z; a1[3] += s1 * w.w;
      a2[0] += s2 * w.x; a2[1] += s2 * w.y; a2[2] += s2 * w.z; a2[3] += s2 * w.w;
    }
#pragma unroll
    for (int e = 0; e < 4; ++e) {
      red[(kg * 3 + 0) * 64 + 4 * c4 + e] = a0[e];
      red[(kg * 3 + 1) * 64 + 4 * c4 + e] = a1[e];
      red[(kg * 3 + 2) * 64 + 4 * c4 + e] = a2[e];
    }
    __syncthreads();
    if (tid < 192) {
      int ci = tid >> 6, col = tid & 63;
      float s = p.in[9][(size_t)l * 6144 + n0 + col];
#pragma unroll
      for (int g = 0; g < 16; ++g) s += red[(g * 3 + ci) * 64 + col];
      ((float*)(p.ws + WS_MODV))[((size_t)l * 3 + ci) * 6144 + n0 + col] = s;
    }
    __syncthreads();
  }
  for (int u = blockIdx.x; u < 16; u += gridDim.x) {
    int idx = u * 256 + tid;
    int pq = idx & 63, ldg = idx >> 6;
    float are = p.in[11][idx], aim = p.in[12][idx];
    float dt = expf(p.in[17][ldg]);
    float x = are * dt, y = aim * dt;
    float ex = expf(x), sy, cy, sh, ch;
    sincos_acc(y, sy, cy);
    sincos_acc(0.5f * y, sh, ch);
    float abr = ex * cy, abi = ex * sy;
    float nre = expm1f(x) * cy - 2.f * sh * sh, nim = ex * sy;
    float den = are * are + aim * aim;
    float fre = (nre * are + nim * aim) / den, fim = (nim * are - nre * aim) / den;
    ((float2*)(p.ws + WS_ABAR))[idx] = make_float2(abr, abi);
    float tr = abr, ti = abi;
#pragma unroll
    for (int i = 0; i < 6; ++i) { float nr = tr * tr - ti * ti, ni = 2.f * tr * ti; tr = nr; ti = ni; }
    ((float2*)(p.ws + WS_AT))[idx] = make_float2(tr, ti);
    u16* bt = (u16*)(p.ws + WS_BBAR) + (size_t)ldg * 2048;
    u16* ct = (u16*)(p.ws + WS_CBT) + (size_t)ldg * 2048;
    unsigned rre[8], rim[8];
#pragma unroll
    for (int c = 0; c < 16; c += 2) {
      float bre0 = p.in[13][(size_t)idx * 16 + c], bim0 = p.in[14][(size_t)idx * 16 + c];
      float bre1 = p.in[13][(size_t)idx * 16 + c + 1], bim1 = p.in[14][(size_t)idx * 16 + c + 1];
      rre[c >> 1] = pack2(fre * bre0 - fim * bim0, fre * bre1 - fim * bim1);
      rim[c >> 1] = pack2(fre * bim0 + fim * bre0, fre * bim1 + fim * bre1);
    }
    uint4* bo = (uint4*)(bt + (size_t)(2 * pq) * 16);
    bo[0] = make_uint4(rre[0], rre[1], rre[2], rre[3]); bo[1] = make_uint4(rre[4], rre[5], rre[6], rre[7]);
    bo[2] = make_uint4(rim[0], rim[1], rim[2], rim[3]); bo[3] = make_uint4(rim[4], rim[5], rim[6], rim[7]);
#pragma unroll
    for (int c = 0; c < 16; ++c) {
      float cr = p.in[15][((size_t)ldg * 16 + c) * 64 + pq], ci = p.in[16][((size_t)ldg * 16 + c) * 64 + pq];
      *(unsigned*)(ct + c * 128 + 2 * pq) = pack2(cr, -ci);
    }
  }
}

DI void phase_prenorm(const P& p, int l, int which, const int wv) {
  const int tid = otid(wv); const int lane = tid & 63, w = tid >> 6;
  u16* hb = (u16*)(p.ws + WS_HBUF);
  const float* modv = (const float*)(p.ws + WS_MODV);
  int ci_cur = -1;
  float4 s4c[4], c4c[4];
#pragma unroll
  for (int i = 0; i < 4; ++i) { s4c[i] = make_float4(0.f, 0.f, 0.f, 0.f); c4c[i] = s4c[i]; }
  for (int T = blockIdx.x * 4 + w; T < NT; T += gridDim.x * 4) {
    const float* xr = (which == 0) ? xrow(p, l, T) : p.out + (size_t)T * DM;
    float4 v[4];
    float ss = 0.f;
#pragma unroll
    for (int i = 0; i < 4; ++i) {
      v[i] = ((const float4*)xr)[lane + 64 * i];
      ss += v[i].x * v[i].x + v[i].y * v[i].y + v[i].z * v[i].z + v[i].w * v[i].w;
    }
    const int ci = cond_idx(T);
    if (ci != ci_cur) {
      const float* sh = modv + ((size_t)l * 3 + ci) * 6144 + (which ? 3 : 0) * 1024;
      const float* sc = sh + 1024;
#pragma unroll
      for (int i = 0; i < 4; ++i) { s4c[i] = ((const float4*)sh)[lane + 64 * i]; c4c[i] = ((const float4*)sc)[lane + 64 * i]; }
      ci_cur = ci;
    }
    ss = wave_sum(ss, lane);
    float r = rsqrtf(ss * (1.f / 1024.f) + EPSF);
#pragma unroll
    for (int i = 0; i < 4; ++i) {
      const float4 s4 = s4c[i], c4 = c4c[i];
      uint2 o;
      o.x = pack2(v[i].x * r * (1.f + c4.x) + s4.x, v[i].y * r * (1.f + c4.y) + s4.y);
      o.y = pack2(v[i].z * r * (1.f + c4.z) + s4.z, v[i].w * r * (1.f + c4.w) + s4.w);
      *(uint2*)(hb + (size_t)T * DM + 4 * (lane + 64 * i)) = o;
    }
  }
}

constexpr int LROW = 144;
DI void gemm_tile(const u16* __restrict__ A, int lda, int m0, const u16* __restrict__ Bt, int ldb, int n0, int K, char* smem, f32x16 (&acc)[2][2], const int tid) {
  const int lane = tid & 63, w = tid >> 6, r = lane & 31, h = lane >> 5, wm = w >> 1, wn = w & 1;
  char* sA = smem;
  char* sB = smem + 2 * 128 * LROW;
#pragma unroll
  for (int a = 0; a < 2; ++a)
#pragma unroll
    for (int b = 0; b < 2; ++b)
#pragma unroll
      for (int i = 0; i < 16; ++i) acc[a][b][i] = 0.f;
  const int lrow = tid >> 3, lkc = tid & 7;
  const u16* ap = A + (size_t)(m0 + lrow) * lda + 8 * lkc;
  const u16* bp = Bt + (size_t)(n0 + lrow) * ldb + 8 * lkc;
  uint4 a00, a01, a02, a03, b00, b01, b02, b03, a10, a11, a12, a13, b10, b11, b12, b13;
  const int nk = K >> 6;
#define G_LD1(RA, RB, I, KT) RA = *(const uint4*)(ap + (size_t)(32 * I) * lda + (KT) * 64); RB = *(const uint4*)(bp + (size_t)(32 * I) * ldb + (KT) * 64);
#define G_ST1(RA, RB, I, BUF) *(uint4*)(sA + (BUF) * 128 * LROW + (lrow + 32 * I) * LROW + 16 * lkc) = RA; *(uint4*)(sB + (BUF) * 128 * LROW + (lrow + 32 * I) * LROW + 16 * lkc) = RB;
#define G_LOAD0(KT) { G_LD1(a00, b00, 0, KT) G_LD1(a01, b01, 1, KT) G_LD1(a02, b02, 2, KT) G_LD1(a03, b03, 3, KT) }
#define G_LOAD1(KT) { G_LD1(a10, b10, 0, KT) G_LD1(a11, b11, 1, KT) G_LD1(a12, b12, 2, KT) G_LD1(a13, b13, 3, KT) }
#define G_STORE0(BUF) { G_ST1(a00, b00, 0, BUF) G_ST1(a01, b01, 1, BUF) G_ST1(a02, b02, 2, BUF) G_ST1(a03, b03, 3, BUF) }
#define G_STORE1(BUF) { G_ST1(a10, b10, 0, BUF) G_ST1(a11, b11, 1, BUF) G_ST1(a12, b12, 2, BUF) G_ST1(a13, b13, 3, BUF) }
#define G_COMPUTE(BUF) { const char* ab = sA + (BUF) * 128 * LROW + (64 * wm + r) * LROW + 16 * h; \
    const char* bb = sB + (BUF) * 128 * LROW + (64 * wn + r) * LROW + 16 * h; \
    _Pragma("unroll") for (int s = 0; s < 4; ++s) { \
      bf16x8 a0 = *(const bf16x8*)(ab + 32 * s), a1 = *(const bf16x8*)(ab + 32 * LROW + 32 * s); \
      bf16x8 b0 = *(const bf16x8*)(bb + 32 * s), b1 = *(const bf16x8*)(bb + 32 * LROW + 32 * s); \
      acc[0][0] = MFMA(a0, b0, acc[0][0]); acc[0][1] = MFMA(a0, b1, acc[0][1]); \
      acc[1][0] = MFMA(a1, b0, acc[1][0]); acc[1][1] = MFMA(a1, b1, acc[1][1]); } }
  G_LOAD0(0)
  G_LOAD1(1)
  __builtin_amdgcn_sched_barrier(0);
  G_STORE0(0)
  if (2 < nk) G_LOAD0(2)
  __syncthreads();
  for (int kt = 0; kt < nk; kt += 2) {
    G_STORE1(1)
    if (kt + 3 < nk) G_LOAD1(kt + 3)
    __builtin_amdgcn_sched_barrier(0);
    __builtin_amdgcn_s_setprio(1);
    G_COMPUTE(0)
    __builtin_amdgcn_s_setprio(0);
    __builtin_amdgcn_sched_barrier(0);
    __syncthreads();
    if (kt + 2 < nk) G_STORE0(0)
    if (kt + 4 < nk) G_LOAD0(kt + 4)
    __builtin_amdgcn_sched_barrier(0);
    __builtin_amdgcn_s_setprio(1);
    G_COMPUTE(1)
    __builtin_amdgcn_s_setprio(0);
    __builtin_amdgcn_sched_barrier(0);
    __syncthreads();
  }
#undef G_LD1
#undef G_ST1
#undef G_LOAD0
#undef G_LOAD1
#undef G_STORE0
#undef G_STORE1
#undef G_COMPUTE
}
template <class F>
DI void epi(const f32x16 (&acc)[2][2], const int tid, F f) {
  const int lane = tid & 63, w = tid >> 6, r = lane & 31, h = lane >> 5, wm = w >> 1, wn = w & 1;
#pragma unroll
  for (int a = 0; a < 2; ++a)
#pragma unroll
    for (int b = 0; b < 2; ++b)
#pragma unroll
      for (int i = 0; i < 16; ++i) f(64 * wm + 32 * a + (i & 3) + 8 * (i >> 2) + 4 * h, 64 * wn + 32 * b + r, acc[a][b][i]);
}


DI void stage_tile(const f32x16 (&acc)[2][2], const int tid, float* U) {
  epi(acc, tid, [&](int lr, int lc, float v) { U[lr * 132 + lc] = v; });
  __syncthreads();
}
DI void store_tile_bf16(const float* U, const int tid, u16* dst, int ld, int m0, int n0, int ncol_valid) {
  const int cg = tid & 15, rg = tid >> 4;
  if (8 * cg < ncol_valid) {
#pragma unroll
    for (int rr = 0; rr < 8; ++rr) {
      const int row = 8 * rg + rr;
      const float4 a = *(const float4*)(U + row * 132 + 8 * cg), b = *(const float4*)(U + row * 132 + 8 * cg + 4);
      uint4 o; o.x = pack2(a.x, a.y); o.y = pack2(a.z, a.w); o.z = pack2(b.x, b.y); o.w = pack2(b.z, b.w);
      *(uint4*)(dst + (size_t)(m0 + row) * ld + n0 + 8 * cg) = o;
    }
  }
  __syncthreads();
}

DI bool next_tile(int it, int ntiles, int GM, int GN, int NMG, int& mt, int& nt) {
  if (false && gridDim.x == 512) {
    const int g = it * 8 + (blockIdx.x & 7);
    if (g * 64 >= ntiles) return false;
    const int slot = blockIdx.x >> 3;
    const int gm = g % NMG, gn = g / NMG;
    mt = gm * GM + slot % GM; nt = gn * GN + slot / GM;
    return true;
  }
  const int t = blockIdx.x + it * gridDim.x;
  if (t >= ntiles) return false;
  mt = t % 96; nt = t / 96;
  return true;
}

DI void phase_zgemm(const P& p, int l, char* smem, const int wv) {
  const int tid = otid(wv);
  const u16* A = (const u16*)(p.ws + WS_HBUF);
  const u16* B = (const u16*)(p.ws + WS_WIN) + (size_t)l * 1280 * 1024;
  u16* z = (u16*)(p.ws + WS_Z);
  for (int it = 0;; ++it) {
    int mt, nt;
    if (!next_tile(it, 960, 32, 2, 3, mt, nt)) break;
    f32x16 acc[2][2];
    gemm_tile(A, 1024, 128 * mt, B, 1024, 128 * nt, 1024, smem, acc, tid);
    stage_tile(acc, tid, (float*)smem);
    store_tile_bf16((const float*)smem, tid, z, INC, 128 * mt, 128 * nt, INC - 128 * nt);
  }
}

DI void phase_postz(const P& p, int l, const int wv) {
  const int tid = otid(wv); const int lane = tid & 63, w = tid >> 6;
  const u16* z = (const u16*)(p.ws + WS_Z);
  u16* cqn = (u16*)(p.ws + WS_CQN);
  u16* ckvn = (u16*)(p.ws + WS_CKVN);
  const float* qan = p.in[20] + l * 256;
  const float* kvan = p.in[21] + l * 128;
  const float4 gq4 = ((const float4*)qan)[lane];
  const float2 gk2 = ((const float2*)kvan)[lane];
  for (int T = blockIdx.x * 4 + w; T < NKV; T += gridDim.x * 4) {
    if (T < NT) {
      const u16* zr = z + (size_t)T * INC;
      uint2 q = *(const uint2*)(zr + 256 + 4 * lane);
      float q0 = bflo(q.x), q1 = bfhi(q.x), q2 = bflo(q.y), q3 = bfhi(q.y);
      float ss = wave_sum(q0 * q0 + q1 * q1 + q2 * q2 + q3 * q3, lane);
      float r = rsqrtf(ss * (1.f / 256.f) + EPSF);
      const float4 g = gq4;
      uint2 o;
      o.x = pack2(q0 * r * g.x, q1 * r * g.y);
      o.y = pack2(q2 * r * g.z, q3 * r * g.w);
      *(uint2*)(cqn + (size_t)T * 256 + 4 * lane) = o;
      unsigned kv = *(const unsigned*)(zr + 512 + 2 * lane);
      float k0 = bflo(kv), k1 = bfhi(kv);
      float s2 = wave_sum(k0 * k0 + k1 * k1, lane);
      float r2 = rsqrtf(s2 * (1.f / 128.f) + EPSF);
      const float2 g2 = gk2;
      float c0 = k0 * r2 * g2.x, c1 = k1 * r2 * g2.y;
      *(unsigned*)(ckvn + (size_t)T * 128 + 2 * lane) = pack2(c0, c1);
      if (T < NCTX) {
        int s = T >> 8, pos = T & 255;
        *(float2*)(p.out + O_CKV + ((size_t)(s * 2 + l) * 256 + pos) * 128 + 2 * lane) = make_float2(c0, c1);
        if (lane < 32) p.out[O_KR + ((size_t)(s * 2 + l) * 256 + pos) * 32 + lane] = bf2f(zr[640 + lane]);
      }
    } else {
      int R = T - NT, b = R >> 8, j = R & 255;
      float2 c = *(const float2*)(p.in[2] + (((size_t)b * 2 + l) * 256 + j) * 128 + 2 * lane);
      *(unsigned*)(ckvn + (size_t)T * 128 + 2 * lane) = pack2(c.x, c.y);
    }
  }
}

typedef __attribute__((ext_vector_type(4))) float f32x4;
#define MFMA16(a, b, c) __builtin_amdgcn_mfma_f32_16x16x32_bf16((a), (b), (c), 0, 0, 0)
constexpr int SSM_WB = 17152;
DI bf16x8 zero8() { bf16x8 z; for (int i = 0; i < 8; ++i) z[i] = 0; return z; }

DI void phase_ssm1(const P& p, int l, char* smem, const int wv) {
  const int tid = otid(wv); const int lane = tid & 63, w = tid >> 6;
  const int q = lane >> 4, tl = lane & 15;
  const u16* z = (const u16*)(p.ws + WS_Z);
  const float2* abar = (const float2*)(p.ws + WS_ABAR);
  float2* S = (float2*)(p.ws + WS_SBUF);
  float* BUl = (float*)(smem + w * SSM_WB);
  for (int ub = blockIdx.x; ub < 1536; ub += gridDim.x) {
    int u = ub * 4 + w;
    int chain, c, L, Tbase;
    if (u < 2048) { chain = u >> 2; c = u & 3; L = 256; Tbase = (chain >> 5) * 256; }
    else { int qq = u - 2048; chain = 512 + (qq >> 6); c = qq & 63; L = 4096; Tbase = NCTX + ((chain - 512) >> 5) * 4096; }
    int d = (chain >> 4) & 1, g = chain & 15;
    int ldg = (l * 2 + d) * 16 + g;
    float2 a = abar[ldg * 64 + lane];
    const u16* bt = (const u16*)(p.ws + WS_BBAR) + (size_t)ldg * 2048;
    bf16x8 bf[8], uf[4];
#pragma unroll
    for (int nb = 0; nb < 8; ++nb) bf[nb] = (q < 2) ? *(const bf16x8*)(bt + (16 * nb + tl) * 16 + 8 * q) : zero8();
#pragma unroll
    for (int sbi = 0; sbi < 4; ++sbi) {
      int tt = 64 * c + 16 * sbi + tl;
      int pos = d ? (L - 1 - tt) : tt;
      uf[sbi] = (q < 2) ? *(const bf16x8*)(z + (size_t)(Tbase + pos) * INC + 16 * g + 8 * q) : zero8();
    }
    float hr = 0.f, hi = 0.f;
#pragma unroll
    for (int sbi = 0; sbi < 4; ++sbi) {
      WSYNC();
#pragma unroll
      for (int nb = 0; nb < 8; ++nb) {
        f32x4 acc = {0.f, 0.f, 0.f, 0.f};
        acc = MFMA16(bf[nb], uf[sbi], acc);
        *(f32x4*)(BUl + tl * 132 + 16 * nb + 4 * q) = acc;
      }
      WSYNC();
#pragma unroll
      for (int st = 0; st < 16; ++st) {
        float2 bu = *(const float2*)(BUl + st * 132 + 2 * lane);
        float nr = fmaf(a.x, hr, fmaf(-a.y, hi, bu.x));
        float ni = fmaf(a.x, hi, fmaf(a.y, hr, bu.y));
        hr = nr; hi = ni;
      }
    }
    S[(size_t)u * 64 + lane] = make_float2(hr, hi);
  }
}

DI void phase_ssm_carry(const P& p, int l, const int wv) {
  const int tid = otid(wv); const int lane = tid & 63, w = tid >> 6;
  const float2* aT = (const float2*)(p.ws + WS_AT);
  const float2* S = (const float2*)(p.ws + WS_SBUF);
  float2* H = (float2*)(p.ws + WS_HST);
  for (int chain = blockIdx.x * 4 + w; chain < 576; chain += gridDim.x * 4) {
    int d = (chain >> 4) & 1, g = chain & 15;
    int ldg = (l * 2 + d) * 16 + g;
    float2 a = aT[ldg * 64 + lane];
    float hr = 0.f, hi = 0.f;
    int nch, ubase;
    if (chain < 512) { nch = 4; ubase = chain * 4; }
    else {
      nch = 64; ubase = 2048 + (chain - 512) * 64;
      int b = (chain - 512) >> 5;
      size_t si = ((((size_t)b * 2 + l) * 2 + d) * 16 + g) * 64 + lane;
      hr = p.in[4][si]; hi = p.in[5][si];
    }
    for (int c0 = 0; c0 < nch; c0 += 16) {
      float2 sv[16];
#pragma unroll
      for (int j = 0; j < 16; ++j) {
        sv[j] = make_float2(0.f, 0.f);
        if (c0 + j < nch) {
          const float* sp = (const float*)(S + (size_t)(ubase + c0 + j) * 64 + lane);
          sv[j].x = __hip_atomic_load(sp, __ATOMIC_RELAXED, __HIP_MEMORY_SCOPE_AGENT);
          sv[j].y = __hip_atomic_load(sp + 1, __ATOMIC_RELAXED, __HIP_MEMORY_SCOPE_AGENT);
        }
      }
#pragma unroll
      for (int j = 0; j < 16; ++j) {
        if (c0 + j < nch) {
          H[(size_t)(ubase + c0 + j) * 64 + lane] = make_float2(hr, hi);
          float nr = fmaf(a.x, hr, fmaf(-a.y, hi, sv[j].x));
          float ni = fmaf(a.x, hi, fmaf(a.y, hr, sv[j].y));
          hr = nr; hi = ni;
        }
      }
    }
    if (chain < 512) {
      int s = chain >> 5;
      size_t oi = ((((size_t)s * 2 + l) * 2 + d) * 16 + g) * 64 + lane;
      p.out[O_SRE + oi] = hr;
      p.out[O_SIM + oi] = hi;
    }
  }
}

DI void phase_ssm2(const P& p, int l, char* smem, const int wv) {
  const int tid = otid(wv); const int lane = tid & 63, w = tid >> 6;
  const int q = lane >> 4, tl = lane & 15;
  const u16* z = (const u16*)(p.ws + WS_Z);
  const float2* abar = (const float2*)(p.ws + WS_ABAR);
  const float2* H = (const float2*)(p.ws + WS_HST);
  u16* ybf = (u16*)(p.ws + WS_YBF);
  float* BUl = (float*)(smem + w * SSM_WB);
  char* Hl = smem + w * SSM_WB + 8448;
  float* yt = (float*)(smem + w * SSM_WB + 12800);
  for (int ub = blockIdx.x; ub < 768; ub += gridDim.x) {
    int u = ub * 4 + w;
    int slot, g, pc, L, Tbase, nchunk;
    if (u < 1024) { slot = u >> 6; g = (u >> 2) & 15; pc = u & 3; L = 256; Tbase = slot * 256; nchunk = 4; }
    else { int qq = u - 1024; int b = qq >> 10; slot = 16 + b; g = (qq >> 6) & 15; pc = qq & 63; L = 4096; Tbase = NCTX + b * 4096; nchunk = 64; }
    (void)L;
    for (int i = lane; i < 64 * 17; i += 64) yt[i] = 0.f;
    const int Tfin = Tbase + 64 * pc + lane;
    const uint4 uf0 = *(const uint4*)(z + (size_t)Tfin * INC + 16 * g), uf1 = *(const uint4*)(z + (size_t)Tfin * INC + 16 * g + 8);
    const float4 dd0 = *(const float4*)(p.in[18] + l * 256 + 16 * g), dd1 = *(const float4*)(p.in[18] + l * 256 + 16 * g + 4),
                 dd2 = *(const float4*)(p.in[18] + l * 256 + 16 * g + 8), dd3 = *(const float4*)(p.in[18] + l * 256 + 16 * g + 12);
#pragma unroll
    for (int d = 0; d < 2; ++d) {
      int ldg = (l * 2 + d) * 16 + g;
      float2 a = abar[ldg * 64 + lane];
      const u16* bt = (const u16*)(p.ws + WS_BBAR) + (size_t)ldg * 2048;
      const u16* ct = (const u16*)(p.ws + WS_CBT) + (size_t)ldg * 2048;
      bf16x8 bf[8], cf[4], uf[4];
#pragma unroll
      for (int nb = 0; nb < 8; ++nb) bf[nb] = (q < 2) ? *(const bf16x8*)(bt + (16 * nb + tl) * 16 + 8 * q) : zero8();
#pragma unroll
      for (int ks = 0; ks < 4; ++ks) cf[ks] = *(const bf16x8*)(ct + tl * 128 + 32 * ks + 8 * q);
#pragma unroll
      for (int sbi = 0; sbi < 4; ++sbi) {
        int tau = 16 * sbi + tl;
        int pl = d ? (63 - tau) : tau;
        uf[sbi] = (q < 2) ? *(const bf16x8*)(z + (size_t)(Tbase + 64 * pc + pl) * INC + 16 * g + 8 * q) : zero8();
      }
      int chain, cidx, hu;
      if (slot < 16) { chain = (slot * 2 + d) * 16 + g; cidx = d ? (nchunk - 1 - pc) : pc; hu = chain * 4 + cidx; }
      else { chain = ((slot - 16) * 2 + d) * 16 + g; cidx = d ? (nchunk - 1 - pc) : pc; hu = 2048 + chain * 64 + cidx; }
      float2 h0 = H[(size_t)hu * 64 + lane];
      float hr = h0.x, hi = h0.y;
#pragma unroll
      for (int sbi = 0; sbi < 4; ++sbi) {
        WSYNC();
#pragma unroll
        for (int nb = 0; nb < 8; ++nb) {
          f32x4 acc = {0.f, 0.f, 0.f, 0.f};
          acc = MFMA16(bf[nb], uf[sbi], acc);
          *(f32x4*)(BUl + tl * 132 + 16 * nb + 4 * q) = acc;
        }
        WSYNC();
#pragma unroll
        for (int st = 0; st < 16; ++st) {
          float2 bu = *(const float2*)(BUl + st * 132 + 2 * lane);
          float nr = fmaf(a.x, hr, fmaf(-a.y, hi, bu.x));
          float ni = fmaf(a.x, hi, fmaf(a.y, hr, bu.y));
          hr = nr; hi = ni;
          *(unsigned*)(Hl + st * 272 + 4 * lane) = pack2(hr, hi);
        }
        WSYNC();
        f32x4 ya = {0.f, 0.f, 0.f, 0.f};
#pragma unroll
        for (int ks = 0; ks < 4; ++ks) {
          bf16x8 hf = *(const bf16x8*)(Hl + tl * 272 + 64 * ks + 16 * q);
          ya = MFMA16(hf, cf[ks], ya);
        }
#pragma unroll
        for (int j = 0; j < 4; ++j) {
          int tau = 16 * sbi + 4 * q + j;
          int pl = d ? (63 - tau) : tau;
          yt[pl * 17 + tl] += ya[j];
        }
      }
    }
    WSYNC();
    {
      const int T = Tfin;
      const uint4 u0 = uf0, u1 = uf1;
      float uu[16] = {bflo(u0.x), bfhi(u0.x), bflo(u0.y), bfhi(u0.y), bflo(u0.z), bfhi(u0.z), bflo(u0.w), bfhi(u0.w),
                      bflo(u1.x), bfhi(u1.x), bflo(u1.y), bfhi(u1.y), bflo(u1.z), bfhi(u1.z), bflo(u1.w), bfhi(u1.w)};
      const float dd[16] = {dd0.x, dd0.y, dd0.z, dd0.w, dd1.x, dd1.y, dd1.z, dd1.w, dd2.x, dd2.y, dd2.z, dd2.w, dd3.x, dd3.y, dd3.z, dd3.w};
      float yv[16];
#pragma unroll
      for (int cc = 0; cc < 16; ++cc) yv[cc] = geluf(yt[lane * 17 + cc] + dd[cc] * uu[cc]);
      uint4 o0, o1;
      o0.x = pack2(yv[0], yv[1]); o0.y = pack2(yv[2], yv[3]); o0.z = pack2(yv[4], yv[5]); o0.w = pack2(yv[6], yv[7]);
      o1.x = pack2(yv[8], yv[9]); o1.y = pack2(yv[10], yv[11]); o1.z = pack2(yv[12], yv[13]); o1.w = pack2(yv[14], yv[15]);
      uint4* op = (uint4*)(ybf + (size_t)T * 256 + 16 * g);
      op[0] = o0; op[1] = o1;
    }
    __syncthreads();
  }
}

DI void phase_qkv_gemm(const P& p, int l, char* smem, const int wv) {
  const int tid = otid(wv);
  const u16* A1 = (const u16*)(p.ws + WS_CQN);
  const u16* B1 = (const u16*)(p.ws + WS_WUQ) + (size_t)l * 768 * 256;
  u16* q = (u16*)(p.ws + WS_QRAW);
  const u16* A2 = (const u16*)(p.ws + WS_CKVN);
  const u16* B2 = (const u16*)(p.ws + WS_WUKV) + (size_t)l * 1024 * 128;
  u16* kv = (u16*)(p.ws + WS_KVRAW);
  for (int t = blockIdx.x; t < 576 + 800; t += gridDim.x) {
    f32x16 acc[2][2];
    if (t < 576) {
      int mt = t % 96, nt = t / 96;
      gemm_tile(A1, 256, 128 * mt, B1, 256, 128 * nt, 256, smem, acc, tid);
      stage_tile(acc, tid, (float*)smem);
      store_tile_bf16((const float*)smem, tid, q, 768, 128 * mt, 128 * nt, 128);
    } else {
      int t2 = t - 576, mt = t2 % 100, nt = t2 / 100;
      gemm_tile(A2, 128, 128 * mt, B2, 128, 128 * nt, 128, smem, acc, tid);
      stage_tile(acc, tid, (float*)smem);
      store_tile_bf16((const float*)smem, tid, kv, 1024, 128 * mt, 128 * nt, 128);
    }
  }
}

DI void phase_gmlp(const P& p, int l, char* smem, const int wv) {
  const int tid = otid(wv), lane = tid & 63, w = tid >> 6, r = lane & 31, h = lane >> 5;
  const u16* z = (const u16*)(p.ws + WS_Z);
  u16* ycat = (u16*)(p.ws + WS_YCAT);
  float* rr = (float*)smem;
  char* vT = smem + 512;
  char* wsm = smem + 512 + 64 * 272;
  for (int u = blockIdx.x; u < 384; u += gridDim.x) {
    int ch = u >> 2, hd = u & 3, T0 = 128 * ch;
    {
      int k = tid >> 1, half = tid & 1;
      const uint4* vp = (const uint4*)(z + (size_t)(T0 + k) * INC + 928 + 128 * half);
      float ss = 0.f;
#pragma unroll
      for (int i = 0; i < 16; ++i) {
        uint4 v = vp[i];
        float a0 = bflo(v.x), a1 = bfhi(v.x), a2 = bflo(v.y), a3 = bfhi(v.y), a4 = bflo(v.z), a5 = bfhi(v.z), a6 = bflo(v.w), a7 = bfhi(v.w);
        ss += a0 * a0 + a1 * a1 + a2 * a2 + a3 * a3 + a4 * a4 + a5 * a5 + a6 * a6 + a7 * a7;
      }
      ss += shx(ss, 1, lane);
      if (half == 0) rr[k] = rsqrtf(ss * (1.f / 256.f) + EPSF);
    }
    __syncthreads();
    {
      int k = tid >> 1, half = tid & 1;
      float rk = rr[k];
      const uint4* vp = (const uint4*)(z + (size_t)(T0 + k) * INC + 928 + 64 * hd + 32 * half);
      const float* gv = p.in[26] + l * 256 + 64 * hd + 32 * half;
#pragma unroll
      for (int i = 0; i < 4; ++i) {
        uint4 v = vp[i];
        float a[8] = {bflo(v.x), bfhi(v.x), bflo(v.y), bfhi(v.y), bflo(v.z), bfhi(v.z), bflo(v.w), bfhi(v.w)};
#pragma unroll
        for (int e = 0; e < 8; ++e) {
          int c = 32 * half + 8 * i + e;
          *(u16*)(vT + c * 272 + 2 * k) = f2bf(a[e] * rk * gv[8 * i + e]);
        }
      }
      const float* wsrc = p.in[27] + ((size_t)l * 4 + hd) * 16384;
      float4 wq[16];
#pragma unroll
      for (int i = 0; i < 16; ++i) { int idx = tid + 256 * i; wq[i] = *(const float4*)(wsrc + (idx >> 5) * 128 + 4 * (idx & 31)); }
      __builtin_amdgcn_sched_barrier(0);
#pragma unroll
      for (int i = 0; i < 16; ++i) {
        int idx = tid + 256 * i, row = idx >> 5, c4 = idx & 31;
        uint2 o; o.x = pack2(wq[i].x, wq[i].y); o.y = pack2(wq[i].z, wq[i].w);
        *(uint2*)(wsm + row * 272 + 8 * c4) = o;
      }
    }
    __syncthreads();
    f32x16 acc[2];
#pragma unroll
    for (int i = 0; i < 16; ++i) { acc[0][i] = 0.f; acc[1][i] = 0.f; }
#pragma unroll
    for (int s = 0; s < 8; ++s) {
      bf16x8 af = *(const bf16x8*)(wsm + (32 * w + r) * 272 + 32 * s + 16 * h);
      bf16x8 b0 = *(const bf16x8*)(vT + r * 272 + 32 * s + 16 * h);
      bf16x8 b1 = *(const bf16x8*)(vT + (32 + r) * 272 + 32 * s + 16 * h);
      acc[0] = MFMA(af, b0, acc[0]);
      acc[1] = MFMA(af, b1, acc[1]);
    }
    const float* bs = p.in[28] + ((size_t)l * 4 + hd) * 128;
    float* Uw = (float*)wsm;
    WSYNC();
#pragma unroll
    for (int cb = 0; cb < 2; ++cb)
#pragma unroll
      for (int i = 0; i < 16; ++i) Uw[(32 * w + (i & 3) + 8 * (i >> 2) + 4 * h) * 68 + 32 * cb + r] = acc[cb][i];
    WSYNC();
    {
      const int cg = lane & 7, rl = lane >> 3;
#pragma unroll
      for (int ps = 0; ps < 4; ++ps) {
        const int q = 32 * w + 8 * ps + rl;
        const float4 m0 = *(const float4*)(Uw + q * 68 + 8 * cg), m1 = *(const float4*)(Uw + q * 68 + 8 * cg + 4);
        const float bq = bs[q];
        const uint4 uv = *(const uint4*)(z + (size_t)(T0 + q) * INC + 672 + 64 * hd + 8 * cg);
        uint4 o;
        o.x = pack2(bflo(uv.x) * (m0.x + bq), bfhi(uv.x) * (m0.y + bq)); o.y = pack2(bflo(uv.y) * (m0.z + bq), bfhi(uv.y) * (m0.w + bq));
        o.z = pack2(bflo(uv.z) * (m1.x + bq), bfhi(uv.z) * (m1.y + bq)); o.w = pack2(bflo(uv.w) * (m1.z + bq), bfhi(uv.w) * (m1.w + bq));
        *(uint4*)(ycat + (size_t)(T0 + q) * 1024 + 768 + 64 * hd + 8 * cg) = o;
      }
    }
    __syncthreads();
  }
}

DI void phase_qprep(const P& p, int l, const int wv) {
  const int tid = otid(wv); const int lane = tid & 63, w = tid >> 6;
  const int hd = lane >> 3, sub = lane & 7;
  const u16* qraw = (const u16*)(p.ws + WS_QRAW);
  u16* Qb = (u16*)(p.ws + WS_QB);
  const float* qn = p.in[24] + l * 96;
  float qg[8];
#pragma unroll
  for (int e = 0; e < 8; ++e) qg[e] = qn[8 * sub + e];
  const float qgp0 = qn[64 + 2 * sub], qgp1 = qn[65 + 2 * sub], qgq0 = qn[80 + 2 * sub], qgq1 = qn[81 + 2 * sub];
  const float qinv0 = exp2f(-(float)((2 * sub) & 7) * (13.287712379549449f / 8.f)), qinv1 = exp2f(-(float)(((2 * sub) & 7) + 1) * (13.287712379549449f / 8.f));
  for (int T = blockIdx.x * 4 + w; T < NT; T += gridDim.x * 4) {
    const u16* qr = qraw + (size_t)T * 768 + 96 * hd;
    uint4 n = *(const uint4*)(qr + 8 * sub);
    unsigned x1 = *(const unsigned*)(qr + 64 + 2 * sub), x2 = *(const unsigned*)(qr + 80 + 2 * sub);
    float a[8] = {bflo(n.x), bfhi(n.x), bflo(n.y), bfhi(n.y), bflo(n.z), bfhi(n.z), bflo(n.w), bfhi(n.w)};
    float p0 = bflo(x1), p1 = bfhi(x1), q0 = bflo(x2), q1 = bfhi(x2);
    float ss = p0 * p0 + p1 * p1 + q0 * q0 + q1 * q1;
#pragma unroll
    for (int e = 0; e < 8; ++e) ss += a[e] * a[e];
    ss += shx(ss, 1, lane); ss += shx(ss, 2, lane); ss += shx(ss, 4, lane);
    float r = rsqrtf(ss * (1.f / 96.f) + EPSF) * ATT_S2;
#pragma unroll
    for (int e = 0; e < 8; ++e) a[e] *= r * qg[e];
    p0 *= r * qgp0; p1 *= r * qgp1;
    q0 *= r * qgq0; q1 *= r * qgq1;
    if (T >= NCTX) {
      int pos = (T - NCTX) & 4095;
      float pp = (sub < 4) ? (float)(pos >> 6) : (float)(pos & 63);
      float s0, c0, s1, c1;
      sincos_acc(pp * qinv0, s0, c0);
      sincos_acc(pp * qinv1, s1, c1);
      float n0 = p0 * c0 - q0 * s0, m0 = q0 * c0 + p0 * s0;
      float n1 = p1 * c1 - q1 * s1, m1 = q1 * c1 + p1 * s1;
      p0 = n0; q0 = m0; p1 = n1; q1 = m1;
    }
    u16* qo = Qb + ((size_t)T * 8 + hd) * 96;
    uint4 o; o.x = pack2(a[0], a[1]); o.y = pack2(a[2], a[3]); o.z = pack2(a[4], a[5]); o.w = pack2(a[6], a[7]);
    *(uint4*)(qo + 8 * sub) = o;
    *(unsigned*)(qo + 64 + 2 * sub) = pack2(p0, p1);
    *(unsigned*)(qo + 80 + 2 * sub) = pack2(q0, q1);
  }
}

DI void phase_kvprep(const P& p, int l, char* smem, const int wv) {
  const int tid = otid(wv), lane = tid & 63, w = tid >> 6;
  const int hd = lane >> 3, sub = lane & 7;
  const u16* kvraw = (const u16*)(p.ws + WS_KVRAW);
  const u16* z = (const u16*)(p.ws + WS_Z);
  u16* Kb = (u16*)(p.ws + WS_KB);
  u16* Vtb = (u16*)(p.ws + WS_VTB);
  const float* kn = p.in[25] + l * 96;
  float kg[8];
#pragma unroll
  for (int e = 0; e < 8; ++e) kg[e] = kn[8 * sub + e];
  const float kgp0 = kn[64 + 2 * sub], kgp1 = kn[65 + 2 * sub], kgq0 = kn[80 + 2 * sub], kgq1 = kn[81 + 2 * sub];
  const float kinv0 = exp2f(-(float)((2 * sub) & 7) * (13.287712379549449f / 8.f)), kinv1 = exp2f(-(float)(((2 * sub) & 7) + 1) * (13.287712379549449f / 8.f));
  for (int u = (int)gridDim.x - 1 - (int)blockIdx.x; u < 200; u += gridDim.x) {
    int R0 = 64 * u;
    int nk, key0; size_t kbase, vbase; int lat_own = 0, pos0 = 0;
    if (R0 < NCTX) { int s = R0 >> 8; nk = 256; key0 = R0 & 255; kbase = (size_t)s * 8 * 256 * 96; vbase = (size_t)s * 8 * 64 * 256; }
    else if (R0 < NT) { int b = (R0 - NCTX) >> 12; pos0 = (R0 - NCTX) & 4095; nk = 4352; key0 = 256 + pos0; lat_own = 1; kbase = K_LAT + (size_t)b * 8 * 4352 * 96; vbase = VT_LAT + (size_t)b * 8 * 64 * 4352; }
    else { int b = (R0 - NT) >> 8; nk = 4352; key0 = (R0 - NT) & 255; kbase = K_LAT + (size_t)b * 8 * 4352 * 96; vbase = VT_LAT + (size_t)b * 8 * 64 * 4352; }
    const bool is_cache = R0 >= NT;
    uint4 n_n, vv_n; unsigned x1_n = 0u, x2_n = 0u; float c0_n = 0.f, c1_n = 0.f, c2_n = 0.f, c3_n = 0.f;
#define KV_PREFETCH(IT) { const int R_ = R0 + 4 * (IT) + w; const u16* kr_ = kvraw + (size_t)R_ * 1024 + 128 * hd; \
      n_n = *(const uint4*)(kr_ + 8 * sub); vv_n = *(const uint4*)(kr_ + 64 + 8 * sub); \
      if (!is_cache) { x1_n = *(const unsigned*)(z + (size_t)R_ * INC + 640 + 2 * sub); x2_n = *(const unsigned*)(z + (size_t)R_ * INC + 656 + 2 * sub); } \
      else { const float* cr_ = p.in[3] + (((size_t)((R_ - NT) >> 8) * 2 + l) * 256 + ((R_ - NT) & 255)) * 32; \
             c0_n = cr_[2 * sub]; c1_n = cr_[2 * sub + 1]; c2_n = cr_[16 + 2 * sub]; c3_n = cr_[17 + 2 * sub]; } }
    KV_PREFETCH(0)
    for (int it = 0; it < 16; ++it) {
      int kl = 4 * it + w;
      const uint4 n = n_n, vv = vv_n; const unsigned x1 = x1_n, x2 = x2_n; const float cc0 = c0_n, cc1 = c1_n, cc2 = c2_n, cc3 = c3_n;
      if (it + 1 < 16) KV_PREFETCH(it + 1)
      __builtin_amdgcn_sched_barrier(0);
      float a[8] = {bflo(n.x), bfhi(n.x), bflo(n.y), bfhi(n.y), bflo(n.z), bfhi(n.z), bflo(n.w), bfhi(n.w)};
      float p0, p1, q0, q1;
      if (!is_cache) { p0 = bflo(x1); p1 = bfhi(x1); q0 = bflo(x2); q1 = bfhi(x2); }
      else { p0 = cc0; p1 = cc1; q0 = cc2; q1 = cc3; }
      float ss = p0 * p0 + p1 * p1 + q0 * q0 + q1 * q1;
#pragma unroll
      for (int e = 0; e < 8; ++e) ss += a[e] * a[e];
      ss += shx(ss, 1, lane); ss += shx(ss, 2, lane); ss += shx(ss, 4, lane);
      float r = rsqrtf(ss * (1.f / 96.f) + EPSF);
#pragma unroll
      for (int e = 0; e < 8; ++e) a[e] *= r * kg[e];
      p0 *= r * kgp0; p1 *= r * kgp1;
      q0 *= r * kgq0; q1 *= r * kgq1;
      if (lat_own) {
        int pos = pos0 + kl;
        float pp = (sub < 4) ? (float)(pos >> 6) : (float)(pos & 63);
        float s0, c0, s1, c1;
        sincos_acc(pp * kinv0, s0, c0);
        sincos_acc(pp * kinv1, s1, c1);
        float n0 = p0 * c0 - q0 * s0, m0 = q0 * c0 + p0 * s0;
        float n1 = p1 * c1 - q1 * s1, m1 = q1 * c1 + p1 * s1;
        p0 = n0; q0 = m0; p1 = n1; q1 = m1;
      }
      u16* ko = Kb + kbase + ((size_t)hd * nk + key0 + kl) * 96;
      uint4 o; o.x = pack2(a[0], a[1]); o.y = pack2(a[2], a[3]); o.z = pack2(a[4], a[5]); o.w = pack2(a[6], a[7]);
      *(uint4*)(ko + 8 * sub) = o;
      *(unsigned*)(ko + 64 + 2 * sub) = pack2(p0, p1);
      *(unsigned*)(ko + 80 + 2 * sub) = pack2(q0, q1);
      u16 ve[8] = {(u16)(vv.x & 0xffff), (u16)(vv.x >> 16), (u16)(vv.y & 0xffff), (u16)(vv.y >> 16), (u16)(vv.z & 0xffff), (u16)(vv.z >> 16), (u16)(vv.w & 0xffff), (u16)(vv.w >> 16)};
#pragma unroll
      for (int e = 0; e < 8; ++e) *(u16*)(smem + (64 * hd + 8 * sub + e) * 144 + 2 * kl) = ve[e];
    }
    __syncthreads();
#pragma unroll
    for (int i = 0; i < 16; ++i) {
      int id = tid + 256 * i, row = id >> 3, kc = id & 7;
      uint4 v = *(const uint4*)(smem + row * 144 + 16 * kc);
      *(uint4*)(Vtb + vbase + (size_t)row * nk + key0 + 8 * kc) = v;
    }
    __syncthreads();
  }
}

DI void phase_attn(const P& p, int l, char* smem, const int wv) {
  const int tid = otid(wv), lane = tid & 63, w = tid >> 6, r = lane & 31, h = lane >> 5;
  const u16* Qb = (const u16*)(p.ws + WS_QB);
  const u16* Kb = (const u16*)(p.ws + WS_KB);
  const u16* Vtb = (const u16*)(p.ws + WS_VTB);
  u16* ycat = (u16*)(p.ws + WS_YCAT);
  char* sK = smem;
  char* sV = smem + 2 * 64 * 208;
  float gq = 0.f, gk = 0.f;
  for (int d = lane; d < 96; d += 64) { gq = fmaxf(gq, fabsf(p.in[24][l * 96 + d])); gk = fmaxf(gk, fabsf(p.in[25][l * 96 + d])); }
  gq = wave_max(gq, lane); gk = wave_max(gk, lane);
  const float M2 = 96.f * gq * gk * ATT_S2;
  u16* ycat2 = (u16*)(p.ws + WS_YCAT2);
  float* lb = (float*)(p.ws + WS_LB);
  for (int uu = blockIdx.x; uu < 768; uu += gridDim.x) {
    int unit = uu;
    if (gridDim.x == 512 && uu < 512) {
      const int slot = uu >> 3;
      unit = (((uu & 7) + 8 * (slot >> 5)) << 5) | (slot & 31);
    }
    int head, qT0, nk, half; const u16 *Kp, *Vp;
    if (unit < 512) { half = unit & 1; int rest = unit >> 1; int b = rest >> 7; head = (rest >> 4) & 7; int qblk = rest & 15; qT0 = NCTX + b * 4096 + 256 * qblk; nk = 4352;
      Kp = Kb + K_LAT + ((size_t)(b * 8 + head) * 4352) * 96; Vp = Vtb + VT_LAT + ((size_t)(b * 8 + head) * 64) * 4352; }
    else { int u2 = unit - 512; half = u2 & 1; int rest = u2 >> 1; int s = rest >> 3; head = rest & 7; qT0 = 256 * s; nk = 256;
      Kp = Kb + ((size_t)(s * 8 + head) * 256) * 96; Vp = Vtb + ((size_t)(s * 8 + head) * 64) * 256; }
    Kp += (size_t)half * (nk >> 1) * 96;
    Vp += half * (nk >> 1);
    bf16x8 qf[2][6];
#pragma unroll
    for (int qb = 0; qb < 2; ++qb)
#pragma unroll
      for (int s = 0; s < 6; ++s)
        qf[qb][s] = *(const bf16x8*)(Qb + ((size_t)(qT0 + 64 * w + 32 * qb + r) * 8 + head) * 96 + 16 * s + 8 * h);
    f32x16 o[2][2];
#pragma unroll
    for (int a = 0; a < 2; ++a)
#pragma unroll
      for (int b = 0; b < 2; ++b)
#pragma unroll
        for (int i = 0; i < 16; ++i) o[a][b][i] = 0.f;
    float lsum[2] = {0.f, 0.f};
    const int kk0 = tid / 12, kc0 = tid % 12, kk1 = (tid + 256) / 12, kc1 = (tid + 256) % 12, kk2 = (tid + 512) / 12, kc2 = (tid + 512) % 12;
    const int vdv0 = tid >> 3, vkc = tid & 7;
    const unsigned ko0 = tid * 8, ko1 = (tid + 256) * 8, ko2 = (tid + 512) * 8;
    const unsigned vo0 = vdv0 * nk + 8 * vkc, vo1 = (vdv0 + 32) * nk + 8 * vkc;
    const int ks0 = kk0 * 208 + 16 * kc0, ks1 = kk1 * 208 + 16 * kc1, ks2 = kk2 * 208 + 16 * kc2;
    const int vs0 = vdv0 * 144 + 16 * vkc, vs1 = (vdv0 + 32) * 144 + 16 * vkc;
    uint4 rk0 = *(const uint4*)(Kp + ko0), rk1 = *(const uint4*)(Kp + ko1), rk2 = *(const uint4*)(Kp + ko2);
    uint4 rv0 = *(const uint4*)(Vp + vo0), rv1 = *(const uint4*)(Vp + vo1);
    *(uint4*)(sK + ks0) = rk0; *(uint4*)(sK + ks1) = rk1; *(uint4*)(sK + ks2) = rk2;
    *(uint4*)(sV + vs0) = rv0; *(uint4*)(sV + vs1) = rv1;
    __syncthreads();
    const int ntile = nk >> 7;
    for (int kt = 0; kt < ntile; ++kt) {
      const int cur = kt & 1;
      if (kt + 1 < ntile) {
        const int k0 = (kt + 1) * 64;
        const u16* Kt = Kp + k0 * 96;
        const u16* Vt = Vp + k0;
        rk0 = *(const uint4*)(Kt + ko0); rk1 = *(const uint4*)(Kt + ko1); rk2 = *(const uint4*)(Kt + ko2);
        rv0 = *(const uint4*)(Vt + vo0); rv1 = *(const uint4*)(Vt + vo1);
      }
      __builtin_amdgcn_sched_barrier(0);
      const char* kbp = sK + cur * 64 * 208;
      const char* vbp = sV + cur * 64 * 144;
      __builtin_amdgcn_s_setprio(1);
#pragma unroll 1
      for (int kb = 0; kb < 2; ++kb) {
        const char* kfp = kbp + (32 * kb + r) * 208 + 16 * h;
#pragma unroll
        for (int qb = 0; qb < 2; ++qb) {
          f32x16 st;
#pragma unroll
          for (int i = 0; i < 16; ++i) st[i] = -M2;
#pragma unroll
          for (int s = 0; s < 6; ++s) st = MFMA(*(const bf16x8*)(kfp + 32 * s), qf[qb][s], st);
          bf16x8 pf[2];
#pragma unroll
          for (int i = 0; i < 16; ++i) { st[i] = __builtin_amdgcn_exp2f(st[i]); lsum[qb] += st[i]; }
#pragma unroll
          for (int sp = 0; sp < 2; ++sp) {
            uint4 pk;
            pk.x = pack2(st[8 * sp + 0], st[8 * sp + 1]); pk.y = pack2(st[8 * sp + 2], st[8 * sp + 3]);
            pk.z = pack2(st[8 * sp + 4], st[8 * sp + 5]); pk.w = pack2(st[8 * sp + 6], st[8 * sp + 7]);
            pf[sp] = __builtin_bit_cast(bf16x8, pk);
          }
#pragma unroll
          for (int sp = 0; sp < 2; ++sp)
#pragma unroll
            for (int dvb = 0; dvb < 2; ++dvb) {
              const char* va = vbp + (32 * dvb + r) * 144 + (32 * kb + 16 * sp + 4 * h) * 2;
              s16x4 lo = *(const s16x4*)(va), hi = *(const s16x4*)(va + 16);
              bf16x8 vf = __builtin_shufflevector(lo, hi, 0, 1, 2, 3, 4, 5, 6, 7);
              o[dvb][qb] = MFMA(vf, pf[sp], o[dvb][qb]);
            }
        }
      }
      __builtin_amdgcn_s_setprio(0);
      if (kt + 1 < ntile) {
        char* wk = sK + (cur ^ 1) * 64 * 208;
        char* wv = sV + (cur ^ 1) * 64 * 144;
        *(uint4*)(wk + ks0) = rk0; *(uint4*)(wk + ks1) = rk1; *(uint4*)(wk + ks2) = rk2;
        *(uint4*)(wv + vs0) = rv0; *(uint4*)(wv + vs1) = rv1;
      }
      __syncthreads();
    }
    char* Ow = smem + w * 9216;
#pragma unroll
    for (int qb = 0; qb < 2; ++qb) {
      float lt = lsum[qb] + shx(lsum[qb], 32, lane);
      float inv = 1.f / lt;
      const int Tq = qT0 + 64 * w + 32 * qb + r;
      if (h == 0) lb[((size_t)Tq * 8 + head) * 2 + half] = lt;
#pragma unroll
      for (int dvb = 0; dvb < 2; ++dvb)
#pragma unroll
        for (int g = 0; g < 4; ++g) {
          uint2 ov;
          ov.x = pack2(o[dvb][qb][4 * g + 0] * inv, o[dvb][qb][4 * g + 1] * inv);
          ov.y = pack2(o[dvb][qb][4 * g + 2] * inv, o[dvb][qb][4 * g + 3] * inv);
          *(uint2*)(Ow + (32 * qb + r) * 144 + (32 * dvb + 8 * g + 4 * h) * 2) = ov;
        }
    }
    WSYNC();
#pragma unroll
    for (int i = 0; i < 8; ++i) {
      const int id = lane + 64 * i, row = id >> 3, kc = id & 7;
      const uint4 v = *(const uint4*)(Ow + row * 144 + 16 * kc);
      const int Tq = qT0 + 64 * w + row;
      u16* yo = half ? (ycat2 + (size_t)Tq * 512 + 64 * head) : (ycat + (size_t)Tq * 1024 + 256 + 64 * head);
      *(uint4*)(yo + 8 * kc) = v;
    }
    __syncthreads();
  }
}

DI void phase_glu(const P& p, int l, char* smem, const int wv) {
  const int tid = otid(wv);
  const u16* A = (const u16*)(p.ws + WS_YBF);
  const u16* B = (const u16*)(p.ws + WS_WGLU) + (size_t)l * 256 * 256;
  u16* ycat = (u16*)(p.ws + WS_YCAT);
  for (int t = blockIdx.x; t < 192; t += gridDim.x) {
    int mt = t % 96, nt = t / 96;
    f32x16 acc[2][2];
    gemm_tile(A, 256, 128 * mt, B, 256, 128 * nt, 256, smem, acc, tid);
    const int m0 = 128 * mt, n0 = 128 * nt;
    float* U = (float*)smem;
    stage_tile(acc, tid, U);
    {
      const int cg = tid & 15, rg = tid >> 4;
#pragma unroll
      for (int rr = 0; rr < 8; ++rr) {
        const int row = 8 * rg + rr;
        const float4 a = *(const float4*)(U + row * 132 + 8 * cg), b = *(const float4*)(U + row * 132 + 8 * cg + 4);
        const uint4 yv = *(const uint4*)(A + (size_t)(m0 + row) * 256 + n0 + 8 * cg);
        uint4 o;
        o.x = pack2(bflo(yv.x) * sigmf(a.x), bfhi(yv.x) * sigmf(a.y)); o.y = pack2(bflo(yv.y) * sigmf(a.z), bfhi(yv.y) * sigmf(a.w));
        o.z = pack2(bflo(yv.z) * sigmf(b.x), bfhi(yv.z) * sigmf(b.y)); o.w = pack2(bflo(yv.w) * sigmf(b.z), bfhi(yv.w) * sigmf(b.w));
        *(uint4*)(ycat + (size_t)(m0 + row) * 1024 + n0 + 8 * cg) = o;
      }
    }
    __syncthreads();
  }
}

DI void phase_merge(const P& p, int l, const int wv) {
  const int tid = otid(wv); const int lane = tid & 63, w = tid >> 6;
  const u16* ycat = (const u16*)(p.ws + WS_YCAT);
  u16* hb = (u16*)(p.ws + WS_HBUF);
  const float* gn = p.in[29] + l * 1024;
  float4 gh[4];
#pragma unroll
  for (int i = 0; i < 4; ++i) gh[i] = ((const float4*)gn)[lane + 64 * i];
  for (int T = blockIdx.x * 4 + w; T < NT; T += gridDim.x * 4) {
    const uint2* yr = (const uint2*)(ycat + (size_t)T * 1024);
    const uint2* yr2 = (const uint2*)((const u16*)(p.ws + WS_YCAT2) + (size_t)T * 512);
    const float2* lb = (const float2*)(p.ws + WS_LB) + (size_t)T * 8;
    float v[4][4];
    float ss[4];
#pragma unroll
    for (int i = 0; i < 4; ++i) {
      uint2 q = yr[lane + 64 * i];
      v[i][0] = bflo(q.x); v[i][1] = bfhi(q.x); v[i][2] = bflo(q.y); v[i][3] = bfhi(q.y);
      if (i == 1 || i == 2) {
        uint2 q2 = yr2[lane + 64 * (i - 1)];
        float2 lw = lb[4 * (i - 1) + (lane >> 4)];
        float w1 = lw.x / (lw.x + lw.y), w2 = lw.y / (lw.x + lw.y);
        v[i][0] = v[i][0] * w1 + bflo(q2.x) * w2; v[i][1] = v[i][1] * w1 + bfhi(q2.x) * w2;
        v[i][2] = v[i][2] * w1 + bflo(q2.y) * w2; v[i][3] = v[i][3] * w1 + bfhi(q2.y) * w2;
      }
      ss[i] = wave_sum(v[i][0] * v[i][0] + v[i][1] * v[i][1] + v[i][2] * v[i][2] + v[i][3] * v[i][3], lane);
    }
    float ra = rsqrtf(ss[0] * (1.f / 256.f) + EPSF);
    float rb = rsqrtf((ss[1] + ss[2]) * (1.f / 512.f) + EPSF);
    float rc = rsqrtf(ss[3] * (1.f / 256.f) + EPSF);
#pragma unroll
    for (int i = 0; i < 4; ++i) {
      float rr = (i == 0) ? ra : (i == 3) ? rc : rb;
      const float4 g = gh[i];
      uint2 o;
      o.x = pack2(v[i][0] * rr * g.x, v[i][1] * rr * g.y);
      o.y = pack2(v[i][2] * rr * g.z, v[i][3] * rr * g.w);
      *(uint2*)(hb + (size_t)T * 1024 + 4 * (lane + 64 * i)) = o;
    }
  }
}

DI void phase_res_gemm(const P& p, int l, int which, char* smem, const int wv) {
  const int tid = otid(wv);
  const u16* A = which == 0 ? (const u16*)(p.ws + WS_HBUF) : (const u16*)(p.ws + WS_ACT);
  const int K = which == 0 ? 1024 : DFF;
  const u16* B = which == 0 ? (const u16*)(p.ws + WS_WOUT) + (size_t)l * 1024 * 1024 : (const u16*)(p.ws + WS_WDN) + (size_t)l * 1024 * DFF;
  const float* modv = (const float*)(p.ws + WS_MODV);
  for (int it = 0;; ++it) {
    int mt, nt;
    if (!next_tile(it, 768, 16, 4, 6, mt, nt)) break;
    const int m0 = 128 * mt, n0 = 128 * nt;
    const float* gate = modv + ((size_t)l * 3 + cond_idx(m0)) * 6144 + (which == 0 ? 2 : 5) * 1024;
    const int lsel = which == 0 ? l : 1;
    const int cgp = tid & 31, rgp = tid >> 5;
    const float4 gt = *(const float4*)(gate + n0 + 4 * cgp);
    float4 xpre[10];
#pragma unroll
    for (int rr = 0; rr < 10; ++rr) xpre[rr] = *(const float4*)(xrow(p, lsel, m0 + 16 * rgp + rr) + n0 + 4 * cgp);
    __builtin_amdgcn_sched_barrier(0);
    f32x16 acc[2][2];
    gemm_tile(A, K, 128 * mt, B, K, 128 * nt, K, smem, acc, tid);
    float* U = (float*)smem;
    stage_tile(acc, tid, U);
    {
      const int cg = cgp, rg = rgp;
#pragma unroll
      for (int rr = 0; rr < 16; ++rr) {
        const int row = 16 * rg + rr, T = m0 + row;
        const float4 a = *(const float4*)(U + row * 132 + 4 * cg);
        const float4 xin = rr < 10 ? xpre[rr < 10 ? rr : 0] : *(const float4*)(xrow(p, lsel, T) + n0 + 4 * cg);
        *(float4*)(p.out + (size_t)T * DM + n0 + 4 * cg) = make_float4(xin.x + gt.x * a.x, xin.y + gt.y * a.y, xin.z + gt.z * a.z, xin.w + gt.w * a.w);
      }
    }
    __syncthreads();
  }
}

DI float4 f4fma3(float4 w0, float4 a, float4 w1, float4 b, float4 w2, float4 c, float4 bias) {
  return make_float4(w0.x * a.x + w1.x * b.x + w2.x * c.x + bias.x, w0.y * a.y + w1.y * b.y + w2.y * c.y + bias.y,
                     w0.z * a.z + w1.z * b.z + w2.z * c.z + bias.z, w0.w * a.w + w1.w * b.w + w2.w * c.w + bias.w);
}
DI void phase_ffn_up(const P& p, int l, char* smem, const int wv) {
  const int tid = otid(wv);
  const u16* A = (const u16*)(p.ws + WS_HBUF);
  const u16* B = (const u16*)(p.ws + WS_WUP) + (size_t)l * 5632 * 1024;
  u16* act = (u16*)(p.ws + WS_ACT);
  float* halo = (float*)(p.ws + WS_HALO);
  const float* cw = p.in[32] + (size_t)l * 3 * 5632;
  const float* cb = p.in[33] + (size_t)l * 5632;
  float* U = (float*)smem;
  for (int it = 0;; ++it) {
    int mt, nt;
    if (!next_tile(it, 4224, 16, 4, 6, mt, nt)) break;
    const int chw = 64 * nt + 4 * (tid & 15);
    const float4 w0g = *(const float4*)(cw + chw), w1g = *(const float4*)(cw + 5632 + chw), w2g = *(const float4*)(cw + 2 * 5632 + chw), bg = *(const float4*)(cb + chw);
    const float4 w0v = *(const float4*)(cw + DFF + chw), w1v = *(const float4*)(cw + 5632 + DFF + chw), w2v = *(const float4*)(cw + 2 * 5632 + DFF + chw), bv = *(const float4*)(cb + DFF + chw);
    __builtin_amdgcn_sched_barrier(0);
    f32x16 acc[2][2];
    gemm_tile(A, 1024, 128 * mt, B, 1024, 128 * nt, 1024, smem, acc, tid);
    epi(acc, tid, [&](int lr, int lc, float v) { U[lr * 132 + lc] = v; });
    __syncthreads();
    const int m0 = 128 * mt;
    {
      const int cg = tid & 15, rq = tid >> 4;
      const int ch = 64 * nt + 4 * cg;
      const float4 z4 = make_float4(0.f, 0.f, 0.f, 0.f);
      const int row0 = 8 * rq;
      const float* ug = U + 4 * cg;
      const float* uv = U + 64 + 4 * cg;
      float4 gm = row0 > 0 ? *(const float4*)(ug + (row0 - 1) * 132) : z4, vm = row0 > 0 ? *(const float4*)(uv + (row0 - 1) * 132) : z4;
      float4 g0 = *(const float4*)(ug + row0 * 132), v0 = *(const float4*)(uv + row0 * 132);
      u16* ap = act + (size_t)m0 * DFF + ch;
#pragma unroll
      for (int rr = 0; rr < 8; ++rr) {
        const int row = row0 + rr;
        float4 gp = row < 127 ? *(const float4*)(ug + (row + 1) * 132) : z4, vp = row < 127 ? *(const float4*)(uv + (row + 1) * 132) : z4;
        float4 g = f4fma3(w0g, gm, w1g, g0, w2g, gp, bg);
        float4 v = f4fma3(w0v, vm, w1v, v0, w2v, vp, bv);
        uint2 o;
        o.x = pack2(siluf(g.x) * v.x, siluf(g.y) * v.y);
        o.y = pack2(siluf(g.z) * v.z, siluf(g.w) * v.w);
        *(uint2*)(ap + (size_t)row * DFF) = o;
        gm = g0; vm = v0; g0 = gp; v0 = vp;
      }
      if (tid < 128) {
        float* hp = halo + ((size_t)mt * 4) * 5632 + 128 * nt + tid;
        hp[0] = U[0 * 132 + tid];
        hp[5632] = U[1 * 132 + tid];
        hp[2 * 5632] = U[126 * 132 + tid];
        hp[3 * 5632] = U[127 * 132 + tid];
      }
    }
    __syncthreads();
  }
}

DI void phase_ffn_fix(const P& p, int l, const int wv) {
  const int tid = otid(wv);
  u16* act = (u16*)(p.ws + WS_ACT);
  const float* halo = (const float*)(p.ws + WS_HALO);
  const float* cw = p.in[32] + (size_t)l * 3 * 5632;
  const float* cb = p.in[33] + (size_t)l * 5632;
  for (int u = blockIdx.x; u < 96 * 11; u += gridDim.x) {
    int mt = u / 11, chunk = u % 11;
    int m0 = 128 * mt;
    bool seq_start = (m0 < NCTX) ? ((m0 & 255) == 0) : (((m0 - NCTX) & 4095) == 0);
    if (seq_start) continue;
    int ch = 256 * chunk + tid;
    int j = ch >> 6, c = ch & 63;
    int ng = 128 * j + c, nv = ng + 64;
    const float* Hm = halo + ((size_t)(mt - 1) * 4) * 5632;
    const float* Hc = halo + ((size_t)mt * 4) * 5632;
    const float w0g = cw[ch], w1g = cw[5632 + ch], w2g = cw[2 * 5632 + ch], bg = cb[ch];
    const float w0v = cw[DFF + ch], w1v = cw[5632 + DFF + ch], w2v = cw[2 * 5632 + DFF + ch], bv = cb[DFF + ch];
    {
      float g = w0g * Hm[3 * 5632 + ng] + w1g * Hc[ng] + w2g * Hc[5632 + ng] + bg;
      float v = w0v * Hm[3 * 5632 + nv] + w1v * Hc[nv] + w2v * Hc[5632 + nv] + bv;
      act[(size_t)m0 * DFF + ch] = f2bf(siluf(g) * v);
    }
    {
      float g = w0g * Hm[2 * 5632 + ng] + w1g * Hm[3 * 5632 + ng] + w2g * Hc[ng] + bg;
      float v = w0v * Hm[2 * 5632 + nv] + w1v * Hm[3 * 5632 + nv] + w2v * Hc[nv] + bv;
      act[(size_t)(m0 - 1) * DFF + ch] = f2bf(siluf(g) * v);
    }
  }
}


#define XB_TMO      128
#define XB_XCNT(j)  (256  + 64 * (j))
#define XB_XSUB(j)  (1280 + 64 * (j))
#define XB_XGEN(j)  (2304 + 64 * (j))
#define XB_TOP      3328
#define XB_TOPGEN   3392
#define XCD_BAR_WORDS 3456
#define XB_SPIN_CAP (1u << 18)
#define LAS __attribute__((address_space(3)))
DI unsigned xb_ld(unsigned* p) { return __hip_atomic_load(p, __ATOMIC_RELAXED, __HIP_MEMORY_SCOPE_AGENT); }
DI unsigned xb_add(unsigned* p, unsigned v) { return __hip_atomic_fetch_add(p, v, __ATOMIC_RELAXED, __HIP_MEMORY_SCOPE_AGENT); }
DI unsigned xb_xcc_id() { return (unsigned)__builtin_amdgcn_s_getreg((3 << 11) | 20) & 0xFu; }
#define XB_SPIN(cond, bar) do { unsigned _sp = 0; while (cond) { __builtin_amdgcn_s_sleep(1); \
    if ((++_sp & 255u) == 0u) { if (xb_ld(&(bar)[XB_TMO])) break; if (_sp > XB_SPIN_CAP) { atomicAdd(&(bar)[XB_TMO], 1u); break; } } } } while (0)
struct XcdBarrier { unsigned* bar; unsigned x; volatile LAS unsigned* st; };
DI XcdBarrier xcd_barrier_post(unsigned* bar, volatile LAS unsigned* st, int tid) {
  XcdBarrier b; b.bar = bar; b.x = xb_xcc_id(); b.st = st;
  if (tid == 0) (void)xb_add(&bar[XB_XCNT(b.x)], 1u);
  return b;
}
DI void xcd_barrier_complete(unsigned* bar, unsigned x, unsigned& nloc, unsigned& nx) {
  const unsigned G = gridDim.x * gridDim.y * gridDim.z;
  unsigned sum, cnt, mine, sp = 0u;
  for (;;) {
    sum = 0u; cnt = 0u; mine = 0u;
#pragma unroll
    for (unsigned j = 0; j < 16; ++j) { const unsigned c = xb_ld(&bar[XB_XCNT(j)]); sum += c; cnt += (c > 0u) ? 1u : 0u; mine = (j == x) ? c : mine; }
    if (sum == G) break;
    __builtin_amdgcn_s_sleep(1);
    if ((++sp & 255u) == 0u) { if (xb_ld(&bar[XB_TMO])) break; if (sp > XB_SPIN_CAP) { atomicAdd(&bar[XB_TMO], 1u); break; } }
  }
  nloc = mine > 0u ? mine : 1u; nx = cnt > 0u ? cnt : 1u;
}
DI void xcd_barrier(const XcdBarrier& b, const int wv) {
  asm volatile("s_waitcnt vmcnt(0)" ::: "memory");
  __syncthreads();
  if (otid(wv) == 0) {
    unsigned* bar = b.bar;
    const unsigned bx = xb_xcc_id();
    __builtin_amdgcn_s_waitcnt(0);
    unsigned nloc = b.st[0], nx = b.st[1];
    if (nloc == 0u) { xcd_barrier_complete(bar, bx, nloc, nx); b.st[0] = nloc; b.st[1] = nx; }
    const unsigned old = xb_add(&bar[XB_XSUB(bx)], 1u);
    const unsigned gen = old / nloc;
    if (old + 1u == (gen + 1u) * nloc) {
      __builtin_amdgcn_fence(__ATOMIC_RELEASE, "agent");
      asm volatile("s_waitcnt vmcnt(0)" ::: "memory");
      const unsigned og = xb_add(&bar[XB_TOP], 1u);
      const unsigned tg = og / nx;
      if (og + 1u == (tg + 1u) * nx) xb_add(&bar[XB_TOPGEN], 1u);
      else XB_SPIN(xb_ld(&bar[XB_TOPGEN]) == tg, bar);
      __builtin_amdgcn_fence(__ATOMIC_ACQUIRE, "agent");
      xb_add(&bar[XB_XGEN(bx)], 1u);
      asm volatile("s_waitcnt vmcnt(0)" ::: "memory");
    } else {
      XB_SPIN(xb_ld(&bar[XB_XGEN(bx)]) == gen, bar);
      __builtin_amdgcn_fence(__ATOMIC_ACQUIRE, "agent");
      asm volatile("s_waitcnt vmcnt(0)" ::: "memory");
    }
  }
  __syncthreads();
}

extern __shared__ __attribute__((aligned(16))) char dyn_smem[];

#ifndef DUP_MASK
#define DUP_MASK 0
#endif
#define RUN(bit, call) do { call; if (DUP_MASK & (1u << (bit))) { xcd_barrier(xbar, wv); call; } } while (0)

__global__ void __launch_bounds__(256, 2) fwd_megakernel(P p) {
  char* smem = dyn_smem;
  const int wv = __builtin_amdgcn_readfirstlane(threadIdx.x >> 6);
  __shared__ uint4 xb_words;
  {
    cg::grid_group grid = cg::this_grid();
    if (p.ws == nullptr) grid.sync();
    if (otid(wv) == 0) xb_words = make_uint4(0u, 0u, 0u, 0u);
    __syncthreads();
  }
  const XcdBarrier xbar = xcd_barrier_post((unsigned*)(p.ws + WS_BAR), (volatile LAS unsigned*)&xb_words, otid(wv));
  RUN(0, phase_prep(p, smem, wv));
  xcd_barrier(xbar, wv);
  for (int l = 0; l < 2; ++l) {
    RUN(1, phase_prenorm(p, l, 0, wv));
    xcd_barrier(xbar, wv);
    RUN(2, phase_zgemm(p, l, smem, wv));
    xcd_barrier(xbar, wv);
    RUN(3, phase_postz(p, l, wv));
    RUN(4, phase_ssm1(p, l, smem, wv));
    xcd_barrier(xbar, wv);
    RUN(5, phase_qkv_gemm(p, l, smem, wv));
    RUN(6, phase_gmlp(p, l, smem, wv));
    RUN(7, phase_ssm_carry(p, l, wv));
    xcd_barrier(xbar, wv);
    RUN(8, phase_qprep(p, l, wv));
    RUN(9, phase_kvprep(p, l, smem, wv));
    RUN(10, phase_ssm2(p, l, smem, wv));
    xcd_barrier(xbar, wv);
    RUN(11, phase_attn(p, l, smem, wv));
    RUN(12, phase_glu(p, l, smem, wv));
    xcd_barrier(xbar, wv);
    RUN(13, phase_merge(p, l, wv));
    xcd_barrier(xbar, wv);
    phase_res_gemm(p, l, 0, smem, wv);
    xcd_barrier(xbar, wv);
    RUN(14, phase_prenorm(p, l, 1, wv));
    xcd_barrier(xbar, wv);
    RUN(15, phase_ffn_up(p, l, smem, wv));
    xcd_barrier(xbar, wv);
    RUN(16, phase_ffn_fix(p, l, wv));
    xcd_barrier(xbar, wv);
    phase_res_gemm(p, l, 1, smem, wv);
    if (l == 0) xcd_barrier(xbar, wv);
  }
  if (DUP_MASK & (1u << 31)) { for (int i = 0; i < 20; ++i) xcd_barrier(xbar, wv); }
}

extern "C" void kernel_launch(void* const* d_in, const int* in_sizes, int n_in, void* d_out, int out_size, void* d_ws, size_t ws_size,
                              hipStream_t stream) {
  static int grid_blocks = 0;
  if (!grid_blocks) {
    int dev = 0, cus = 0, per_cu = 0;
    hipGetDevice(&dev);
    hipDeviceGetAttribute(&cus, hipDeviceAttributeMultiprocessorCount, dev);
    hipFuncSetAttribute((const void*)fwd_megakernel, hipFuncAttributeMaxDynamicSharedMemorySize, SMEM_BYTES);
    hipOccupancyMaxActiveBlocksPerMultiprocessor(&per_cu, fwd_megakernel, 256, SMEM_BYTES);
    if (per_cu < 1) per_cu = 1;
    if (per_cu > 2) per_cu = 2;
    grid_blocks = cus * per_cu;
    if (ws_size < WS_TOTAL) fprintf(stderr, "workspace too small: %zu < %zu\n", ws_size, (size_t)WS_TOTAL);
  }
  (void)hipMemsetAsync(d_ws, 0, 16384, stream);
  P p{};
  for (int i = 0; i < 35; ++i) p.in[i] = (const float*)d_in[i];
  p.out = (float*)d_out;
  p.ws = (char*)d_ws;
  void* args[] = {&p};
  hipError_t e = hipLaunchCooperativeKernel((void*)fwd_megakernel, dim3(grid_blocks), dim3(256), args, SMEM_BYTES, stream);
  if (e != hipSuccess) fprintf(stderr, "cooperative launch failed: %s (grid %d)\n", hipGetErrorString(e), grid_blocks);
}
```
